# Optimizing an MI355X kernel written in HIP

```python
import math
import jax
import jax.numpy as jnp
from jax import lax
import numpy as np

D_MODEL = 1024
BATCH = 4
SEQ = 4096
DEPTH = 2

MLSTM_HEADS = 4
MLSTM_WIDTH = 768
MLSTM_HD = MLSTM_WIDTH // MLSTM_HEADS
MLSTM_CONV = 4
GLA_HEADS = 4
GLA_WIDTH = 768
GLA_KEY_WIDTH = GLA_WIDTH // 2
GLA_DK = GLA_KEY_WIDTH // GLA_HEADS
GLA_DV = GLA_WIDTH // GLA_HEADS
GLA_GATE_RANK = 16
GLA_GATE_TAU = 16.0
S5_WIDTH = 512
S5_GROUP = 16
S5_GROUPS = S5_WIDTH // S5_GROUP
S5_STATE = 64
DT_MIN = 1e-3
DT_MAX = 1e-1
CHUNK = 64
EPS = 1e-6
IN_SIZES = (MLSTM_WIDTH, MLSTM_WIDTH, MLSTM_WIDTH, MLSTM_WIDTH, MLSTM_HEADS, MLSTM_HEADS, MLSTM_WIDTH,
            GLA_KEY_WIDTH, GLA_KEY_WIDTH, GLA_WIDTH, GLA_GATE_RANK, GLA_WIDTH,
            S5_WIDTH, S5_WIDTH,
            3 * D_MODEL)
IN_WIDTH = sum(IN_SIZES)

kernel_name = 'hybrid_mlstm_gla_s5_gated_block'


def rmsnorm(x, w):
    xf = x.astype(jnp.float32)
    y = xf * lax.rsqrt(jnp.mean(xf * xf, axis=-1, keepdims=True) + EPS)
    return (y * w.astype(jnp.float32)).astype(x.dtype)


def head_norm(x, w, n_heads, center):
    b, l, width = x.shape
    xh = x.astype(jnp.float32).reshape(b, l, n_heads, width // n_heads)
    if center:
        xh = xh - jnp.mean(xh, axis=-1, keepdims=True)
    xh = xh * lax.rsqrt(jnp.mean(xh * xh, axis=-1, keepdims=True) + EPS)
    return xh.reshape(b, l, width) * w.astype(jnp.float32)


def causal_dwconv(x, w):
    taps = w.shape[0]
    l = x.shape[1]
    xp = jnp.pad(x, ((0, 0), (taps - 1, 0), (0, 0)))
    return sum(xp[:, j:j + l] * w[j] for j in range(taps))


def to_chunks(x, n_heads):
    b, l, width = x.shape
    x = x.reshape(b, l // CHUNK, CHUNK, n_heads, width // n_heads)
    return x.transpose(1, 0, 3, 2, 4)


def from_chunks(y):
    n, b, h, t, d = y.shape
    return y.transpose(1, 0, 3, 2, 4).reshape(b, n * t, h * d)


def gate_chunks(g):
    b, l, h = g.shape
    return g.reshape(b, l // CHUNK, CHUNK, h).transpose(1, 0, 3, 2)


def mlstm_chunkwise(q, k, v, i_pre, logf):
    b, l, _ = q.shape
    h, d = MLSTM_HEADS, MLSTM_HD
    qc = to_chunks(q, h)
    kc = to_chunks(k * d ** -0.5, h)
    vc = to_chunks(v, h)
    ic = gate_chunks(i_pre)
    fc = gate_chunks(logf)
    causal = jnp.tril(jnp.ones((CHUNK, CHUNK), dtype=bool))

    def step(carry, inp):
        c_mat, n_vec, m = carry
        qt, kt, vt, it, ft = inp
        bcum = jnp.cumsum(ft, axis=-1)
        dmat = bcum[..., :, None] - bcum[..., None, :] + it[..., None, :]
        dmat = jnp.where(causal, dmat, -jnp.inf)
        inter = bcum + m[..., None]
        m_t = jnp.maximum(inter, jnp.max(dmat, axis=-1))
        w_intra = jnp.exp(dmat - m_t[..., None])
        w_inter = jnp.exp(inter - m_t)
        s = jnp.einsum('bhtd,bhsd->bhts', qt, kt) * w_intra
        num = (jnp.einsum('bhts,bhse->bhte', s, vt)
               + w_inter[..., None] * jnp.einsum('bhtd,bhde->bhte', qt, c_mat))
        den = jnp.sum(s, axis=-1) + w_inter * jnp.einsum('bhtd,bhd->bht', qt, n_vec)
        out = num / jnp.maximum(jnp.abs(den), jnp.exp(-m_t))[..., None]
        b_end = bcum[..., -1]
        to_end = b_end[..., None] - bcum + it
        m_new = jnp.maximum(b_end + m, jnp.max(to_end, axis=-1))
        wk = jnp.exp(to_end - m_new[..., None])
        w_prev = jnp.exp(b_end + m - m_new)
        c_new = w_prev[..., None, None] * c_mat + jnp.einsum('bhs,bhsd,bhse->bhde', wk, kt, vt)
        n_new = w_prev[..., None] * n_vec + jnp.einsum('bhs,bhsd->bhd', wk, kt)
        return (c_new, n_new, m_new), out

    init = (jnp.zeros((b, h, d, d), jnp.float32), jnp.zeros((b, h, d), jnp.float32),
            jnp.zeros((b, h), jnp.float32))
    _, ys = lax.scan(step, init, (qc, kc, vc, ic, fc))
    return from_chunks(ys)


def gla_chunkwise(q, k, v, log_a):
    b, l, _ = q.shape
    h = GLA_HEADS
    qc = to_chunks(q * GLA_DK ** -0.5, h)
    kc = to_chunks(k, h)
    vc = to_chunks(v, h)
    ac = to_chunks(log_a, h)
    causal = jnp.tril(jnp.ones((CHUNK, CHUNK), dtype=bool))[:, :, None]

    def step(state, inp):
        qt, kt, vt, at = inp
        bcum = jnp.cumsum(at, axis=2)
        diff = bcum[:, :, :, None, :] - bcum[:, :, None, :, :]
        decay = jnp.exp(jnp.where(causal, diff, -jnp.inf))
        attn = jnp.einsum('bhtd,bhsd,bhtsd->bhts', qt, kt, decay)
        out = (jnp.einsum('bhts,bhse->bhte', attn, vt)
               + jnp.einsum('bhtd,bhde->bhte', qt * jnp.exp(bcum), state))
        last = bcum[:, :, -1:, :]
        new_state = (jnp.exp(last[:, :, 0])[..., None] * state
                     + jnp.einsum('bhsd,bhse->bhde', kt * jnp.exp(last - bcum), vt))
        return new_state, out

    init = jnp.zeros((b, h, GLA_DK, GLA_DV), jnp.float32)
    _, ys = lax.scan(step, init, (qc, kc, vc, ac))
    return from_chunks(ys)


def s5_ssm(u, lam_re, lam_im, log_dt, b_re, b_im, c_re, c_im, d_skip):
    f32 = jnp.float32
    bsz, l, _ = u.shape
    ug = u.reshape(bsz, l, S5_GROUPS, S5_GROUP)
    lr = jnp.minimum(lam_re.astype(f32), -1e-4)
    li = lam_im.astype(f32)
    dt = jnp.exp(log_dt.astype(f32))[:, None]
    mag = jnp.exp(lr * dt)
    ab_re = mag * jnp.cos(li * dt)
    ab_im = mag * jnp.sin(li * dt)
    nr = ab_re - 1.0
    den = lr * lr + li * li
    coef_re = (nr * lr + ab_im * li) / den
    coef_im = (ab_im * lr - nr * li) / den
    br, bi = b_re.astype(f32), b_im.astype(f32)
    bb_re = coef_re[..., None] * br - coef_im[..., None] * bi
    bb_im = coef_re[..., None] * bi + coef_im[..., None] * br
    bu_re = jnp.einsum('blgh,gph->blgp', ug, bb_re)
    bu_im = jnp.einsum('blgh,gph->blgp', ug, bb_im)
    a_re = jnp.broadcast_to(ab_re, bu_re.shape)
    a_im = jnp.broadcast_to(ab_im, bu_re.shape)

    def combine(e1, e2):
        a1r, a1i, b1r, b1i = e1
        a2r, a2i, b2r, b2i = e2
        return (a2r * a1r - a2i * a1i, a2r * a1i + a2i * a1r,
                a2r * b1r - a2i * b1i + b2r, a2r * b1i + a2i * b1r + b2i)

    _, _, x_re, x_im = lax.associative_scan(combine, (a_re, a_im, bu_re, bu_im), axis=1)
    y = (jnp.einsum('blgp,ghp->blgh', x_re, c_re.astype(f32))
         - jnp.einsum('blgp,ghp->blgh', x_im, c_im.astype(f32)))
    return y.reshape(bsz, l, S5_WIDTH) + d_skip.astype(f32) * u


def hybrid_layer(x, norm_w, w_in, mlstm_conv, mlstm_gate_b, mlstm_norm, gla_w_alpha, gla_b_alpha,
                 gla_norm, s5_lam_re, s5_lam_im, s5_log_dt, s5_B_re, s5_B_im, s5_C_re, s5_C_im,
                 s5_D, s5_w_glu, w_branch_mlstm, w_branch_gla, w_branch_s5, w_out):
    f32 = jnp.float32
    dt = x.dtype
    hn = rmsnorm(x, norm_w)
    proj = hn @ w_in
    split_at = np.cumsum(IN_SIZES)[:-1].tolist()
    (aq, ak, av, ao, ai, af, az, bq, bk, bv, ba, bz, cu, cz, g) = jnp.split(proj, split_at, axis=-1)

    qk = jax.nn.silu(causal_dwconv(jnp.concatenate([aq, ak], axis=-1), mlstm_conv))
    aq, ak = jnp.split(qk, 2, axis=-1)
    i_pre = (ai + mlstm_gate_b[0]).astype(f32)
    logf = jax.nn.log_sigmoid((af + mlstm_gate_b[1]).astype(f32))
    ha = mlstm_chunkwise(aq.astype(f32), ak.astype(f32), av.astype(f32), i_pre, logf)
    ha = head_norm(ha, mlstm_norm, MLSTM_HEADS, True).astype(dt)
    ya = jax.nn.sigmoid(ao) * ha * jax.nn.silu(az)

    log_a = jax.nn.log_sigmoid((ba @ gla_w_alpha + gla_b_alpha).astype(f32)) / GLA_GATE_TAU
    hb = gla_chunkwise(bq.astype(f32), bk.astype(f32), bv.astype(f32), log_a)
    yb = head_norm(hb, gla_norm, GLA_HEADS, False).astype(dt) * jax.nn.silu(bz)

    yc = jax.nn.gelu(s5_ssm(cu.astype(f32), s5_lam_re, s5_lam_im, s5_log_dt, s5_B_re, s5_B_im,
                            s5_C_re, s5_C_im, s5_D)).astype(dt)
    yc = yc * jax.nn.sigmoid(yc @ s5_w_glu) * jax.nn.silu(cz)

    ga, gb, gc = jnp.split(jax.nn.sigmoid(g), 3, axis=-1)
    merged = ga * (ya @ w_branch_mlstm) + gb * (yb @ w_branch_gla) + gc * (yc @ w_branch_s5)
    return x + merged @ w_out


def setup_inputs(seed: int = 0) -> dict:
    key = jax.random.key(seed)
    ks = jax.random.split(key, 24)

    def nrm(k, shape, scale):
        return scale * jax.random.normal(k, shape, jnp.float32)

    x = nrm(ks[0], (BATCH, SEQ, D_MODEL), 1.0)
    norm_w = 1.0 + nrm(ks[1], (DEPTH, D_MODEL), 0.02)
    w_in = nrm(ks[2], (DEPTH, D_MODEL, IN_WIDTH), D_MODEL ** -0.5)
    mlstm_conv = nrm(ks[3], (DEPTH, MLSTM_CONV, 2 * MLSTM_WIDTH), MLSTM_CONV ** -0.5)
    f_bias = jnp.linspace(3.0, 6.0, MLSTM_HEADS, dtype=jnp.float32)
    mlstm_gate_b = jnp.stack([nrm(ks[4], (DEPTH, MLSTM_HEADS), 0.1),
                              f_bias + nrm(ks[5], (DEPTH, MLSTM_HEADS), 0.1)], axis=1)
    mlstm_norm = 1.0 + nrm(ks[6], (DEPTH, MLSTM_WIDTH), 0.02)
    gla_w_alpha = nrm(ks[7], (DEPTH, GLA_GATE_RANK, GLA_KEY_WIDTH), GLA_GATE_RANK ** -0.5)
    gla_b_alpha = nrm(ks[8], (DEPTH, GLA_KEY_WIDTH), 0.1)
    gla_norm = 1.0 + nrm(ks[9], (DEPTH, GLA_WIDTH), 0.02)
    s5_lam_re = -0.5 + nrm(ks[10], (DEPTH, S5_GROUPS, S5_STATE), 0.01)
    s5_lam_im = (math.pi * jnp.arange(S5_STATE, dtype=jnp.float32)
                 + nrm(ks[11], (DEPTH, S5_GROUPS, S5_STATE), 0.01))
    s5_log_dt = jax.random.uniform(ks[12], (DEPTH, S5_GROUPS), jnp.float32,
                                   math.log(DT_MIN), math.log(DT_MAX))
    s5_B_re = nrm(ks[13], (DEPTH, S5_GROUPS, S5_STATE, S5_GROUP), (2 * S5_GROUP) ** -0.5)
    s5_B_im = nrm(ks[14], (DEPTH, S5_GROUPS, S5_STATE, S5_GROUP), (2 * S5_GROUP) ** -0.5)
    s5_C_re = nrm(ks[15], (DEPTH, S5_GROUPS, S5_GROUP, S5_STATE), S5_STATE ** -0.5)
    s5_C_im = nrm(ks[16], (DEPTH, S5_GROUPS, S5_GROUP, S5_STATE), S5_STATE ** -0.5)
    s5_D = nrm(ks[17], (DEPTH, S5_WIDTH), 0.5)
    s5_w_glu = nrm(ks[18], (DEPTH, S5_WIDTH, S5_WIDTH), S5_WIDTH ** -0.5)
    w_branch_mlstm = nrm(ks[19], (DEPTH, MLSTM_WIDTH, D_MODEL), MLSTM_WIDTH ** -0.5)
    w_branch_gla = nrm(ks[20], (DEPTH, GLA_WIDTH, D_MODEL), GLA_WIDTH ** -0.5)
    w_branch_s5 = nrm(ks[21], (DEPTH, S5_WIDTH, D_MODEL), S5_WIDTH ** -0.5)
    w_out = nrm(ks[22], (DEPTH, D_MODEL, D_MODEL), 0.5 * D_MODEL ** -0.5)
    final_norm = 1.0 + nrm(ks[23], (D_MODEL,), 0.02)
    return {'x': x, 'norm_w': norm_w, 'w_in': w_in, 'mlstm_conv': mlstm_conv,
            'mlstm_gate_b': mlstm_gate_b, 'mlstm_norm': mlstm_norm, 'gla_w_alpha': gla_w_alpha,
            'gla_b_alpha': gla_b_alpha, 'gla_norm': gla_norm, 's5_lam_re': s5_lam_re,
            's5_lam_im': s5_lam_im, 's5_log_dt': s5_log_dt, 's5_B_re': s5_B_re, 's5_B_im': s5_B_im,
            's5_C_re': s5_C_re, 's5_C_im': s5_C_im, 's5_D': s5_D, 's5_w_glu': s5_w_glu,
            'w_branch_mlstm': w_branch_mlstm, 'w_branch_gla': w_branch_gla,
            'w_branch_s5': w_branch_s5, 'w_out': w_out, 'final_norm': final_norm}


def reference(x, norm_w, w_in, mlstm_conv, mlstm_gate_b, mlstm_norm, gla_w_alpha, gla_b_alpha,
              gla_norm, s5_lam_re, s5_lam_im, s5_log_dt, s5_B_re, s5_B_im, s5_C_re, s5_C_im,
              s5_D, s5_w_glu, w_branch_mlstm, w_branch_gla, w_branch_s5, w_out, final_norm):
    for layer in range(DEPTH):
        x = hybrid_layer(x, norm_w[layer], w_in[layer], mlstm_conv[layer], mlstm_gate_b[layer],
                         mlstm_norm[layer], gla_w_alpha[layer], gla_b_alpha[layer], gla_norm[layer],
                         s5_lam_re[layer], s5_lam_im[layer], s5_log_dt[layer], s5_B_re[layer],
                         s5_B_im[layer], s5_C_re[layer], s5_C_im[layer], s5_D[layer],
                         s5_w_glu[layer], w_branch_mlstm[layer], w_branch_gla[layer],
                         w_branch_s5[layer], w_out[layer])
    return rmsnorm(x, final_norm)
```

```cpp
#include <hip/hip_runtime.h>
#include <hip/hip_cooperative_groups.h>
#include <cstdio>
namespace cg = cooperative_groups;
namespace pg8 {
#define PG8_LAS __attribute__((address_space(3)))
typedef unsigned short bf16_t;
typedef short bf16x8 __attribute__((ext_vector_type(8)));
typedef float f32x4 __attribute__((ext_vector_type(4)));
typedef unsigned u32x4 __attribute__((ext_vector_type(4)));
constexpr int BM = 256, BK = 64, HALF = 128, HTB = HALF * BK * 2  , STAGE_BYTES = 8 * HTB, NXCD = 8, WGM = 8;

__host__ __device__ __forceinline__ int lds_byte(int r, int c) { const int st = (r >> 4) * 2 + (c >> 5), rr = r & 15, cc = c & 31, ob = rr * 64 + cc * 2; return st * 1024 + (ob ^ (((ob >> 9) & 1) << 5)); }
__host__ __device__ __forceinline__ void stage_rc(int b, int& R, int& C) { const int st = b / 1024, sb = b % 1024, swz = sb ^ (((sb >> 9) & 1) << 5); R = (st >> 1) * 16 + swz / 64; C = (st & 1) * 32 + (swz % 64) / 2; }
__host__ __device__ __forceinline__ int perm32(int rho) { const int n = rho >> 4, i = rho & 15; return 8 * (i >> 2) + 4 * n + (i & 3); }

struct Unit { int pm, pn; };
struct Gemm { const bf16_t* A; const bf16_t* Bt; int M, N, K; };

struct StaticOrder {
    int nM, nN, nwg, G, c;
    __host__ __device__ void init(int M, int N, int G_, int c_) { nM = M / BM; nN = N / BM; nwg = nM * nN; G = G_; c = c_; }
    __host__ __device__ bool next(int i, Unit& u) const {
        const long L = (long)i * G + c; if (L >= nwg) return false;
        int wgid = (int)L; { const int q = nwg / NXCD, r = nwg % NXCD, xcd = wgid % NXCD, off = wgid / NXCD; wgid = (xcd < r ? xcd * (q + 1) : r * (q + 1) + (xcd - r) * q) + off; }
        const int nig = WGM * nN, gid = wgid / nig, fm = gid * WGM, gsz = (nM - fm) < WGM ? (nM - fm) : WGM;
        u.pm = fm + ((wgid % nig) % gsz); u.pn = (wgid % nig) / gsz; return true;
    }
    __device__ __forceinline__ void a_ready(const Unit&) const {}
    __device__ __forceinline__ void done(const Unit&) const {}
};
__device__ __forceinline__ unsigned cvt_pk_bf16(float lo, float hi) { unsigned r; asm volatile("v_cvt_pk_bf16_f32 %0, %1, %2" : "=v"(r) : "v"(lo), "v"(hi)); return r; }
typedef float f32x2 __attribute__((ext_vector_type(2)));
template <class Epi, class Sched, bool STAMP = false>
__device__ __forceinline__ void gemm_phase(PG8_LAS unsigned char* lds, const Gemm g, const Sched& S, const Epi& E, unsigned long long* stamps) {
    int tid_l = threadIdx.x; asm volatile("" : "+v"(tid_l)); const int tid = tid_l, wid = __builtin_amdgcn_readfirstlane(tid >> 6), lane = tid & 63, wr = wid >> 2, wc = wid & 3, fr = lane & 15, fq = lane >> 4;
    const int K = g.K, nt = K / BK;
    int ts_lo = 0, ts_hi = 0, nts = 0; const unsigned long long rt_entry = STAMP ? (unsigned long long)wall_clock64() : 0ull;
#define PG8_STAMP() do { if (STAMP && wid == 0 && nts < 64) { const unsigned long long _c = (unsigned long long)clock64(); \
        ts_lo = (lane == nts) ? (int)(unsigned)_c : ts_lo; ts_hi = (lane == nts) ? (int)(unsigned)(_c >> 32) : ts_hi; ++nts; } } while (0)
    PG8_STAMP();
    unsigned voffA[2], voffB[2];
#pragma unroll
    for (int i = 0; i < 2; ++i) { int R, C; stage_rc(tid * 16 + i * 8192, R, C); const int Rb = Epi::PERM ? ((R & ~31) + perm32(R & 31)) : R;
        voffA[i] = (unsigned)(R * K + C) * 2u; voffB[i] = (unsigned)(Rb * K + C) * 2u; }
    const size_t kstep = (size_t)(BK * 2);
    const size_t hstep = (size_t)HALF * K * 2;
    const size_t tstep = 2 * hstep;
    const unsigned ldsw = (unsigned)wid * 1024u;
    const int aoff = lds_byte(wr * 64 + fr, fq * 8), boff = lds_byte(wc * 32 + fr, fq * 8);
#define PG8_SA(b, h) (((b) * 2 + (h)) * HTB)
#define PG8_SB(b, h) ((4 + (b) * 2 + (h)) * HTB)
#define PG8_STAGE(bufoff, gbase, voff) do { _Pragma("unroll") for (int _i = 0; _i < 2; ++_i) \
        __builtin_amdgcn_global_load_lds((const unsigned*)((const char*)(gbase) + (voff)[_i]), (PG8_LAS unsigned*)(lds + (bufoff) + ldsw + _i * 8192), 16, 0, 0); } while (0)
#define PG8_LDA(dst, b, h) do { _Pragma("unroll") for (int m = 0; m < 4; ++m) _Pragma("unroll") for (int k = 0; k < 2; ++k) dst[m][k] = *(const PG8_LAS bf16x8*)(lds + PG8_SA(b, h) + aoff + m * 2048 + k * 1024); } while (0)
#define PG8_LDB(dst, b, h) do { _Pragma("unroll") for (int n = 0; n < 2; ++n) _Pragma("unroll") for (int k = 0; k < 2; ++k) dst[n][k] = *(const PG8_LAS bf16x8*)(lds + PG8_SB(b, h) + boff + n * 2048 + k * 1024); } while (0)
#define PG8_MMA(ai, bj, At, Bt) do { __builtin_amdgcn_s_setprio(1); _Pragma("unroll") for (int m = 0; m < 4; ++m) _Pragma("unroll") for (int n = 0; n < 2; ++n) _Pragma("unroll") for (int k = 0; k < 2; ++k) \
        acc[ai][bj][m][n] = __builtin_amdgcn_mfma_f32_16x16x32_bf16(Bt[n][k], At[m][k], acc[ai][bj][m][n], 0, 0, 0); __builtin_amdgcn_s_setprio(0); } while (0)
#define PG8_WAIT_V(n) asm volatile("s_waitcnt vmcnt(" #n ")" ::: "memory")
#define PG8_WAIT_L(n) asm volatile("s_waitcnt lgkmcnt(" #n ")" ::: "memory")
#define PG8_BAR __builtin_amdgcn_s_barrier()
#define PG8_SCHED __builtin_amdgcn_sched_barrier(0)
    Unit cur, nxt; int ui = 0;
    if (!S.next(0, cur)) return;
    f32x4 acc[2][2][4][2];
#pragma unroll
    for (int a = 0; a < 2; ++a)
#pragma unroll
        for (int b = 0; b < 2; ++b)
#pragma unroll
            for (int m = 0; m < 4; ++m)
#pragma unroll
                for (int n = 0; n < 2; ++n) acc[a][b][m][n] = (f32x4){0.f, 0.f, 0.f, 0.f};
    bf16x8 At[4][2], B0[2][2], B1[2][2];
    const char* cA = (const char*)g.A + (size_t)cur.pm * tstep; const char* cB = (const char*)g.Bt + (size_t)cur.pn * tstep;
    S.a_ready(cur);
    PG8_STAGE(PG8_SB(0, 0), cB, voffB); PG8_STAGE(PG8_SA(0, 0), cA, voffA); PG8_STAGE(PG8_SB(0, 1), cB + hstep, voffB); PG8_STAGE(PG8_SA(0, 1), cA + hstep, voffA);
    if (wr == 1) PG8_BAR;
    PG8_WAIT_V(4); PG8_BAR;
    PG8_STAGE(PG8_SB(1, 0), cB + kstep, voffB); PG8_STAGE(PG8_SA(1, 0), cA + kstep, voffA); PG8_STAGE(PG8_SB(1, 1), cB + hstep + kstep, voffB);
    PG8_WAIT_V(6); PG8_BAR;
    PG8_STAMP();
    for (;;) {
        const bool has_next = S.next(ui + 1, nxt);
        const char* nA = has_next ? (const char*)g.A + (size_t)nxt.pm * tstep : cA; const char* nB = has_next ? (const char*)g.Bt + (size_t)nxt.pn * tstep : cB;
        for (int t = 0; t < nt; t += 2) {
            const bool last = (t == nt - 2);
            const char* a1 = cA + (size_t)(t + 1) * kstep;
            const char* a2 = last ? nA : cA + (size_t)(t + 2) * kstep; const char* b2 = last ? nB : cB + (size_t)(t + 2) * kstep;
            const char* a3 = a2 + kstep; const char* b3 = b2 + kstep;
            if (last && has_next) S.a_ready(nxt);
            PG8_LDB(B0, 0, 0); PG8_SCHED; PG8_LDA(At, 0, 0); PG8_STAGE(PG8_SA(1, 1), a1 + hstep, voffA);
            PG8_WAIT_L(8); PG8_BAR; PG8_WAIT_L(0); PG8_MMA(0, 0, At, B0); PG8_BAR; PG8_SCHED;
            PG8_LDB(B1, 0, 1); PG8_STAGE(PG8_SB(0, 0), b2, voffB);
            PG8_BAR; PG8_WAIT_L(0); PG8_MMA(0, 1, At, B1); PG8_BAR;
            PG8_LDA(At, 0, 1); PG8_STAGE(PG8_SA(0, 0), a2, voffA);
            PG8_BAR; PG8_WAIT_L(0); PG8_MMA(1, 0, At, B0); PG8_BAR; PG8_SCHED;
            PG8_STAGE(PG8_SB(0, 1), b2 + hstep, voffB);
            PG8_WAIT_V(6); PG8_BAR; PG8_MMA(1, 1, At, B1); PG8_BAR;
            PG8_LDB(B0, 1, 0); PG8_SCHED; PG8_LDA(At, 1, 0); PG8_STAGE(PG8_SA(0, 1), a2 + hstep, voffA);
            PG8_WAIT_L(8); PG8_BAR; PG8_WAIT_L(0); PG8_MMA(0, 0, At, B0); PG8_BAR; PG8_SCHED;
            PG8_LDB(B1, 1, 1); PG8_STAGE(PG8_SB(1, 0), b3, voffB);
            PG8_BAR; PG8_WAIT_L(0); PG8_MMA(0, 1, At, B1); PG8_BAR;
            PG8_LDA(At, 1, 1); PG8_STAGE(PG8_SA(1, 0), a3, voffA);
            PG8_BAR; PG8_WAIT_L(0); PG8_MMA(1, 0, At, B0); PG8_BAR; PG8_SCHED;
            PG8_STAGE(PG8_SB(1, 1), b3 + hstep, voffB);
            PG8_WAIT_V(6); PG8_BAR; PG8_MMA(1, 1, At, B1); PG8_BAR;
        }
        PG8_STAMP();
        if constexpr (!Epi::AFTER_DRAIN) { E(acc, cur, wr, wc, fr, fq); S.done(cur); }
        PG8_STAMP();
        if (!has_next) break;
#pragma unroll
        for (int a = 0; a < 2; ++a)
#pragma unroll
            for (int b = 0; b < 2; ++b)
#pragma unroll
                for (int m = 0; m < 4; ++m)
#pragma unroll
                    for (int n = 0; n < 2; ++n) acc[a][b][m][n] = (f32x4){0.f, 0.f, 0.f, 0.f};
        cur = nxt; cA = nA; cB = nB; ++ui;
    }
    PG8_WAIT_V(0);
    if (wr == 0) PG8_BAR;
    PG8_BAR;
    if constexpr (Epi::AFTER_DRAIN) { E.fused(acc, cur, wr, wc, fr, fq, lds, wid, lane); S.done(cur); }
    PG8_STAMP();
    if (STAMP && wid == 0) { stamps[lane] = lane < nts ? (((unsigned long long)(unsigned)ts_hi << 32) | (unsigned)ts_lo) : 0ull;
        if (lane == 62) stamps[62] = rt_entry; if (lane == 63) stamps[63] = (unsigned long long)wall_clock64(); }
#undef PG8_STAMP
#undef PG8_SA
#undef PG8_SB
#undef PG8_STAGE
#undef PG8_LDA
#undef PG8_LDB
#undef PG8_MMA
#undef PG8_WAIT_V
#undef PG8_WAIT_L
#undef PG8_BAR
#undef PG8_SCHED
}
}

#define LAS __attribute__((address_space(3)))
using pg8::bf16_t; using pg8::bf16x8; using pg8::f32x4; using pg8::u32x4; using pg8::Unit; using pg8::cvt_pk_bf16;
typedef unsigned u32x2 __attribute__((ext_vector_type(2)));
typedef float f32x2v __attribute__((ext_vector_type(2)));

constexpr int MTOK = 16384, DM = 1024, SEQ = 4096;
constexpr int NTHR = 512;
constexpr int LDS_BYTES = 131072;
constexpr int N1A = 5120, N1B = 5376;
constexpr int NSTAT = 6;

constexpr size_t OFF_W1A = 0;
constexpr size_t OFF_W1B = OFF_W1A + (size_t)N1A * 1024 * 2;
constexpr size_t OFF_WGLU = OFF_W1B + (size_t)N1B * 1024 * 2;
constexpr size_t OFF_WBR = OFF_WGLU + (size_t)512 * 512 * 2;
constexpr size_t OFF_WOUT = OFF_WBR + (size_t)3 * 1024 * 768 * 2;
constexpr size_t OFF_XW = OFF_WOUT + (size_t)1024 * 1024 * 2;
constexpr size_t OFF_RSS = OFF_XW + (size_t)MTOK * 1024 * 2;
constexpr size_t OFF_Y = OFF_RSS + (size_t)MTOK * 16 * 4;
constexpr size_t OFF_SG = OFF_Y + (size_t)3 * MTOK * 768 * 2;
constexpr size_t OFF_CU = OFF_SG + (size_t)MTOK * 3072 * 2;
constexpr size_t OFF_SCZ = OFF_CU + (size_t)MTOK * 512 * 2;
constexpr size_t OFF_SMALL = OFF_SCZ + (size_t)MTOK * 512 * 2;
constexpr size_t OFF_MERGED = OFF_SMALL + (size_t)MTOK * 32 * 4;
constexpr size_t OFF_STA = OFF_MERGED + (size_t)MTOK * 1024 * 2;
constexpr size_t OFF_STB = OFF_STA + (size_t)MTOK * 4 * NSTAT * 2 * 4;
constexpr size_t OFF_RSTD = OFF_STB + (size_t)MTOK * 4 * NSTAT * 4;
constexpr size_t WS_END = OFF_RSTD + (size_t)MTOK * 4;

struct Params { const float* in[23]; float* out; unsigned char* ws; };

__device__ __forceinline__ float bf2f(unsigned v) { return __uint_as_float(v << 16); }
__device__ __forceinline__ bf16_t f2bf(float f) { unsigned u = __float_as_uint(f); u += 0x7FFFu + ((u >> 16) & 1u); return (bf16_t)(u >> 16); }
__device__ __forceinline__ float sigmoidf_(float x) { return __builtin_amdgcn_rcpf(1.0f + __expf(-x)); }
__device__ __forceinline__ float siluf_(float x) { return x * sigmoidf_(x); }
__device__ __forceinline__ float logsigmoidf_(float x) { return fminf(x, 0.0f) - log1pf(__expf(-fabsf(x))); }
__device__ __forceinline__ float geluf_(float x) { const float u = 0.7978845608028654f * (x + 0.044715f * x * x * x); const float t = 1.0f - 2.0f * __builtin_amdgcn_rcpf(1.0f + __expf(2.0f * u)); return 0.5f * x * (1.0f + t); }
__device__ __forceinline__ void unpack8(const u32x4 w, float (&f)[8]) {
    f[0] = __uint_as_float(w.x << 16); f[1] = __uint_as_float(w.x & 0xffff0000u); f[2] = __uint_as_float(w.y << 16); f[3] = __uint_as_float(w.y & 0xffff0000u);
    f[4] = __uint_as_float(w.z << 16); f[5] = __uint_as_float(w.z & 0xffff0000u); f[6] = __uint_as_float(w.w << 16); f[7] = __uint_as_float(w.w & 0xffff0000u);
}
__device__ __forceinline__ u32x4 pack8(const float (&f)[8]) { u32x4 w; w.x = cvt_pk_bf16(f[0], f[1]); w.y = cvt_pk_bf16(f[2], f[3]); w.z = cvt_pk_bf16(f[4], f[5]); w.w = cvt_pk_bf16(f[6], f[7]); return w; }
__device__ __forceinline__ float row_rstd(const float* rss, int row) {
    const f32x4* p = (const f32x4*)(rss + (size_t)row * 16); const f32x4 a = p[0], b = p[1], c = p[2], d = p[3];
    const float s = ((a[0] + a[1]) + (a[2] + a[3])) + ((b[0] + b[1]) + (b[2] + b[3])) + ((c[0] + c[1]) + (c[2] + c[3])) + ((d[0] + d[1]) + (d[2] + d[3]));
    return rsqrtf(s * (1.0f / 1024.0f) + 1e-6f);
}

struct EpiG1a {
    static constexpr bool PERM = true, AFTER_DRAIN = false;
    const float* rss; bf16_t* aqk; bf16_t* bqk; bf16_t* y0; bf16_t* y1; bf16_t* cu; bf16_t* scz; float* small;
    __device__ __forceinline__ void operator()(const f32x4 (&acc)[2][2][4][2], const Unit& u, int wr, int wc, int fr, int fq) const {
        const int pn = u.pn; const int row0 = u.pm * 256 + wr * 64 + fr;
        if (pn == 19) {
            if (wc == 0) {
#pragma unroll
                for (int ai = 0; ai < 2; ++ai)
#pragma unroll
                    for (int m = 0; m < 4; ++m) { const int row = row0 + ai * 128 + m * 16; const float rs = rss[row]; float* rp = small + (size_t)row * 32 + 8 * fq;
                        *(f32x4*)(rp) = acc[ai][0][m][0] * rs; *(f32x4*)(rp + 4) = acc[ai][0][m][1] * rs; }
            }
            return;
        }
        bf16_t* base; int ldc, colt; bool act = false;
        if (pn < 6) { base = aqk; ldc = 1536; colt = pn * 256; }
        else if (pn < 9) { base = y0; ldc = 768; colt = (pn - 6) * 256; }
        else if (pn < 12) { base = bqk; ldc = 768; colt = (pn - 9) * 256; }
        else if (pn < 15) { base = y1; ldc = 768; colt = (pn - 12) * 256; }
        else if (pn < 17) { base = cu; ldc = 512; colt = (pn - 15) * 256; }
        else { base = scz; ldc = 512; colt = (pn - 17) * 256; act = true; }
        const int col0 = colt + wc * 32 + 8 * fq;
#pragma unroll
        for (int ai = 0; ai < 2; ++ai)
#pragma unroll
            for (int m = 0; m < 4; ++m) { const int row = row0 + ai * 128 + m * 16; const float rs = rss[row]; bf16_t* rowp = base + (size_t)row * ldc + col0;
#pragma unroll
                for (int bj = 0; bj < 2; ++bj) { f32x4 v0 = acc[ai][bj][m][0] * rs, v1 = acc[ai][bj][m][1] * rs;
                    if (act) {
#pragma unroll
                        for (int j = 0; j < 4; ++j) { v0[j] = siluf_(v0[j]); v1[j] = siluf_(v1[j]); } }
                    u32x4 w; w.x = cvt_pk_bf16(v0[0], v0[1]); w.y = cvt_pk_bf16(v0[2], v0[3]); w.z = cvt_pk_bf16(v1[0], v1[1]); w.w = cvt_pk_bf16(v1[2], v1[3]);
                    *(u32x4*)(rowp + bj * 128) = w; } asm volatile("" ::: "memory"); }
    }
};
struct EpiG1b {
    static constexpr bool PERM = true, AFTER_DRAIN = false;
    const float* rss; bf16_t* y0; bf16_t* y1; bf16_t* sg; const float* sta; const float* stb; const float* anorm; const float* bnorm;
    __device__ __forceinline__ void operator()(const f32x4 (&acc)[2][2][4][2], const Unit& u, int wr, int wc, int fr, int fq) const {
        const int pn = u.pn; const int row0 = u.pm * 256 + wr * 64 + fr;
        if (pn < 6) {
            const int ch = pn * 128 + wc * 32 + 8 * fq, hd = ch / 192;
            float nw[8];
            { const f32x4 a = *(const f32x4*)(anorm + ch), b = *(const f32x4*)(anorm + ch + 4); nw[0] = a[0]; nw[1] = a[1]; nw[2] = a[2]; nw[3] = a[3]; nw[4] = b[0]; nw[5] = b[1]; nw[6] = b[2]; nw[7] = b[3]; }
#pragma unroll
            for (int ai = 0; ai < 2; ++ai)
#pragma unroll
                for (int m = 0; m < 4; ++m) { const int row = row0 + ai * 128 + m * 16; const float rs = rss[row];
                    const f32x4* sp = (const f32x4*)(sta + ((size_t)row * 4 + hd) * (NSTAT * 2)); float s1 = 0.f, s2 = 0.f;
#pragma unroll
                    for (int q = 0; q < NSTAT / 2; ++q) { const f32x4 t = sp[q]; s1 += t[0] + t[2]; s2 += t[1] + t[3]; }
                    const float mean = s1 * (1.0f / 192.0f); const float var = fmaxf(s2 * (1.0f / 192.0f) - mean * mean, 0.0f); const float hr = rsqrtf(var + 1e-6f);
                    bf16_t* yp = y0 + (size_t)row * 768 + ch; float hv[8]; unpack8(*(const u32x4*)yp, hv);
                    const f32x4 o0 = acc[ai][0][m][0] * rs, o1 = acc[ai][0][m][1] * rs, z0 = acc[ai][1][m][0] * rs, z1 = acc[ai][1][m][1] * rs; float r[8];
#pragma unroll
                    for (int j = 0; j < 4; ++j) { r[j] = sigmoidf_(o0[j]) * siluf_(z0[j]) * ((hv[j] - mean) * hr * nw[j]); r[4 + j] = sigmoidf_(o1[j]) * siluf_(z1[j]) * ((hv[4 + j] - mean) * hr * nw[4 + j]); }
                    *(u32x4*)yp = pack8(r); asm volatile("" ::: "memory"); }
        } else if (pn < 9) {
#pragma unroll
            for (int bj = 0; bj < 2; ++bj) { const int ch = (pn - 6) * 256 + bj * 128 + wc * 32 + 8 * fq, hd = ch / 192;
                float nw[8];
                { const f32x4 a = *(const f32x4*)(bnorm + ch), b = *(const f32x4*)(bnorm + ch + 4); nw[0] = a[0]; nw[1] = a[1]; nw[2] = a[2]; nw[3] = a[3]; nw[4] = b[0]; nw[5] = b[1]; nw[6] = b[2]; nw[7] = b[3]; }
#pragma unroll
                for (int ai = 0; ai < 2; ++ai)
#pragma unroll
                    for (int m = 0; m < 4; ++m) { const int row = row0 + ai * 128 + m * 16; const float rs = rss[row];
                        const f32x2v* sp = (const f32x2v*)(stb + ((size_t)row * 4 + hd) * NSTAT); float s2 = 0.f;
#pragma unroll
                        for (int q = 0; q < NSTAT / 2; ++q) { const f32x2v t = sp[q]; s2 += t[0] + t[1]; }
                        const float hr = rsqrtf(s2 * (1.0f / 192.0f) + 1e-6f);
                        bf16_t* yp = y1 + (size_t)row * 768 + ch; float hv[8]; unpack8(*(const u32x4*)yp, hv);
                        const f32x4 z0 = acc[ai][bj][m][0] * rs, z1 = acc[ai][bj][m][1] * rs; float r[8];
#pragma unroll
                        for (int j = 0; j < 4; ++j) { r[j] = siluf_(z0[j]) * (hv[j] * hr * nw[j]); r[4 + j] = siluf_(z1[j]) * (hv[4 + j] * hr * nw[4 + j]); }
                        *(u32x4*)yp = pack8(r); asm volatile("" ::: "memory"); } }
        } else {
            const int col0 = (pn - 9) * 256 + wc * 32 + 8 * fq;
#pragma unroll
            for (int ai = 0; ai < 2; ++ai)
#pragma unroll
                for (int m = 0; m < 4; ++m) { const int row = row0 + ai * 128 + m * 16; const float rs = rss[row]; bf16_t* rowp = sg + (size_t)row * 3072 + col0;
#pragma unroll
                    for (int bj = 0; bj < 2; ++bj) { const f32x4 v0 = acc[ai][bj][m][0] * rs, v1 = acc[ai][bj][m][1] * rs; float r[8];
#pragma unroll
                        for (int j = 0; j < 4; ++j) { r[j] = sigmoidf_(v0[j]); r[4 + j] = sigmoidf_(v1[j]); }
                        *(u32x4*)(rowp + bj * 128) = pack8(r); } asm volatile("" ::: "memory"); }
        }
    }
};
struct EpiG2 {
    static constexpr bool PERM = true, AFTER_DRAIN = false;
    const bf16_t* ycp; const bf16_t* scz; bf16_t* y2;
    __device__ __forceinline__ void operator()(const f32x4 (&acc)[2][2][4][2], const Unit& u, int wr, int wc, int fr, int fq) const {
        const int row0 = u.pm * 256 + wr * 64 + fr, col0 = u.pn * 256 + wc * 32 + 8 * fq;
#pragma unroll
        for (int ai = 0; ai < 2; ++ai)
#pragma unroll
            for (int m = 0; m < 4; ++m) { const int row = row0 + ai * 128 + m * 16;
#pragma unroll
                for (int bj = 0; bj < 2; ++bj) { const int col = col0 + bj * 128; float a[8], z[8], r[8];
                    unpack8(*(const u32x4*)(ycp + (size_t)row * 512 + col), a); unpack8(*(const u32x4*)(scz + (size_t)row * 512 + col), z);
                    const f32x4 v0 = acc[ai][bj][m][0], v1 = acc[ai][bj][m][1];
#pragma unroll
                    for (int j = 0; j < 4; ++j) { r[j] = a[j] * sigmoidf_(v0[j]) * z[j]; r[4 + j] = a[4 + j] * sigmoidf_(v1[j]) * z[4 + j]; }
                    *(u32x4*)(y2 + (size_t)row * 768 + col) = pack8(r); } asm volatile("" ::: "memory"); }
    }
};
struct EpiG3 {
    static constexpr bool PERM = true, AFTER_DRAIN = false;
    const bf16_t* sg; bf16_t* merged;
    __device__ __forceinline__ void operator()(const f32x4 (&acc)[2][2][4][2], const Unit& u, int wr, int wc, int fr, int fq) const {
        const int br = u.pm >> 6, pm = u.pm & 63, pn = u.pn & 3;
        const int row0 = pm * 256 + wr * 64 + fr, col0 = pn * 256 + wc * 32 + 8 * fq;
#pragma unroll
        for (int ai = 0; ai < 2; ++ai)
#pragma unroll
            for (int m = 0; m < 4; ++m) { const int row = row0 + ai * 128 + m * 16;
#pragma unroll
                for (int bj = 0; bj < 2; ++bj) { const int col = col0 + bj * 128; float g[8], r[8];
                    unpack8(*(const u32x4*)(sg + (size_t)row * 3072 + br * 1024 + col), g);
                    const f32x4 v0 = acc[ai][bj][m][0], v1 = acc[ai][bj][m][1];
                    bf16_t* mp = merged + (size_t)row * 1024 + col;
                    if (br == 0) {
#pragma unroll
                        for (int j = 0; j < 4; ++j) { r[j] = g[j] * v0[j]; r[4 + j] = g[4 + j] * v1[j]; }
                    } else { float pv[8]; unpack8(*(const u32x4*)mp, pv);
#pragma unroll
                        for (int j = 0; j < 4; ++j) { r[j] = pv[j] + g[j] * v0[j]; r[4 + j] = pv[4 + j] + g[4 + j] * v1[j]; } }
                    *(u32x4*)mp = pack8(r); } asm volatile("" ::: "memory"); }
    }
};
struct EpiG4 {
    static constexpr bool PERM = false, AFTER_DRAIN = false;
    const float* xprev; float* xnew; bf16_t* xw; const float* nwn; float* rss; int write_xw;
    __device__ __forceinline__ void operator()(const f32x4 (&acc)[2][2][4][2], const Unit& u, int wr, int wc, int fr, int fq) const {
        const int row0 = u.pm * 256 + wr * 64 + fr, col0 = u.pn * 256 + wc * 32 + 4 * fq;
        f32x4 nv[2][2];
#pragma unroll
        for (int bj = 0; bj < 2; ++bj)
#pragma unroll
            for (int n = 0; n < 2; ++n) nv[bj][n] = *(const f32x4*)(nwn + col0 + bj * 128 + n * 16);
#pragma unroll
        for (int ai = 0; ai < 2; ++ai)
#pragma unroll
            for (int m = 0; m < 4; ++m) { const int row = row0 + ai * 128 + m * 16; const size_t off = (size_t)row * 1024 + col0; float ss = 0.f;
#pragma unroll
                for (int bj = 0; bj < 2; ++bj)
#pragma unroll
                    for (int n = 0; n < 2; ++n) { const f32x4 xv = *(const f32x4*)(xprev + off + bj * 128 + n * 16) + acc[ai][bj][m][n];
                        *(f32x4*)(xnew + off + bj * 128 + n * 16) = xv; ss += (xv[0] * xv[0] + xv[1] * xv[1]) + (xv[2] * xv[2] + xv[3] * xv[3]);
                        if (write_xw) { const f32x4 t = xv * nv[bj][n]; u32x2 w; w.x = cvt_pk_bf16(t[0], t[1]); w.y = cvt_pk_bf16(t[2], t[3]); *(u32x2*)(xw + off + bj * 128 + n * 16) = w; } }
                ss += __shfl_xor(ss, 16); ss += __shfl_xor(ss, 32);
                if (fq == 0) rss[(size_t)row * 16 + u.pn * 4 + wc] = ss; asm volatile("" ::: "memory"); }
    }
};
struct BranchOrder {
    int G, c;
    __device__ bool next(int i, Unit& u) const {
        const int j = i / 3, br = i - 3 * j; const long L = (long)j * G + c; if (L >= 256) return false;
        int wgid = (int)L; { const int q = 256 / 8, xcd = wgid % 8, off = wgid / 8; wgid = xcd * q + off; }
        const int nig = 8 * 4, gid = wgid / nig, fm = gid * 8; const int pm = fm + ((wgid % nig) % 8), pn = (wgid % nig) / 8;
        u.pm = br * 64 + pm; u.pn = br * 4 + pn; return true;
    }
    __device__ __forceinline__ void a_ready(const Unit&) const {}
    __device__ __forceinline__ void done(const Unit&) const {}
};

template <int KK> __device__ __forceinline__ f32x4 mma_tile(const LAS bf16_t* A, int lda, int r0, const LAS bf16_t* Bt, int ldb, int c0, f32x4 acc, int lane) {
    const int fr = lane & 15, fq = lane >> 4;
    const LAS bf16_t* ap = A + (r0 + fr) * lda + fq * 8; const LAS bf16_t* bp = Bt + (c0 + fr) * ldb + fq * 8;
#pragma unroll
    for (int k = 0; k < KK; k += 32) { const bf16x8 a = *(const LAS bf16x8*)(ap + k); const bf16x8 b = *(const LAS bf16x8*)(bp + k); acc = __builtin_amdgcn_mfma_f32_16x16x32_bf16(a, b, acc, 0, 0, 0); }
    return acc;
}
__device__ __forceinline__ float wave_scan_add(float v, int lane) {
#pragma unroll
    for (int o = 1; o < 64; o <<= 1) { const float t = __shfl_up(v, o); if (lane >= o) v += t; }
    return v;
}
__device__ __forceinline__ float wave_scan_max(float v, int lane) {
#pragma unroll
    for (int o = 1; o < 64; o <<= 1) { const float t = __shfl_up(v, o); if (lane >= o) v = fmaxf(v, t); }
    return v;
}

__device__ __forceinline__ int colmap(int type, int n) {
    if (type == 1) {
        if (n < 2304) return n;
        if (n < 3072) return 3848 + (n - 2304);
        if (n < 3840) return 4616 + (n - 3072);
        if (n < 4352) return 6168 + (n - 3840);
        if (n < 4864) return 6680 + (n - 4352);
        const int j = n - 4864; if (j < 4) return 3072 + j; if (j < 8) return 3076 + (j - 4); if (j < 24) return 5384 + (j - 8); return -1;
    }
    if (type == 2) {
        if (n < 1536) { const int t = n >> 8, hf = (n >> 7) & 1, x = n & 127; return (hf ? 3080 : 2304) + 128 * t + x; }
        if (n < 2304) return 5400 + (n - 1536);
        return 7192 + (n - 2304);
    }
    return n;
}
__device__ void convert_job(LAS float* tl, const float* src, int lds_, int ks, bf16_t* dst, int kd, int nrows, int type, int G, int c) {
    int tid_l = threadIdx.x; asm volatile("" : "+v"(tid_l)); const int tid = tid_l; const int nkt = kd / 64, nnt = nrows / 64, ntiles = nkt * nnt;
    for (int t = c; t < ntiles; t += G) {
        const int kt = t % nkt, nt = t / nkt; const int k0 = kt * 64, n0 = nt * 64;
        { const int nn = tid & 63; const int sc = colmap(type, n0 + nn);
#pragma unroll
          for (int i = 0; i < 8; ++i) { const int kk = (tid >> 6) + 8 * i; float v = 0.f; if (sc >= 0 && (k0 + kk) < ks) v = src[(size_t)(k0 + kk) * lds_ + sc]; tl[nn * 65 + kk] = v; } }
        __syncthreads();
        { const int nn = tid >> 3, kseg = tid & 7; float f[8];
#pragma unroll
          for (int j = 0; j < 8; ++j) f[j] = tl[nn * 65 + kseg * 8 + j];
          *(u32x4*)(dst + (size_t)(n0 + nn) * kd + k0 + kseg * 8) = pack8(f); }
        __syncthreads();
    }
}
__device__ void phase_convert(LAS unsigned char* lds, const Params& p, int layer) {
    LAS float* tl = (LAS float*)lds; const int G = gridDim.x, c = blockIdx.x; unsigned char* ws = p.ws;
    const float* w_in = p.in[2] + (size_t)layer * 1024 * 10264;
    convert_job(tl, w_in, 10264, 1024, (bf16_t*)(ws + OFF_W1A), 1024, N1A, 1, G, c);
    convert_job(tl, w_in, 10264, 1024, (bf16_t*)(ws + OFF_W1B), 1024, N1B, 2, G, c);
    convert_job(tl, p.in[17] + (size_t)layer * 512 * 512, 512, 512, (bf16_t*)(ws + OFF_WGLU), 512, 512, 0, G, c);
    convert_job(tl, p.in[18] + (size_t)layer * 768 * 1024, 1024, 768, (bf16_t*)(ws + OFF_WBR), 768, 1024, 0, G, c);
    convert_job(tl, p.in[19] + (size_t)layer * 768 * 1024, 1024, 768, (bf16_t*)(ws + OFF_WBR) + (size_t)1024 * 768, 768, 1024, 0, G, c);
    convert_job(tl, p.in[20] + (size_t)layer * 512 * 1024, 1024, 512, (bf16_t*)(ws + OFF_WBR) + (size_t)2 * 1024 * 768, 768, 1024, 0, G, c);
    convert_job(tl, p.in[21] + (size_t)layer * 1024 * 1024, 1024, 1024, (bf16_t*)(ws + OFF_WOUT), 1024, 1024, 0, G, c);
    if (layer > 0) { const float* rss = (const float*)(ws + OFF_RSS); float* rstd = (float*)(ws + OFF_RSTD); for (int row = c * NTHR + threadIdx.x; row < MTOK; row += G * NTHR) rstd[row] = row_rstd(rss, row); }
}
__device__ void phase_prologue_x(const Params& p) {
    const int tid = threadIdx.x, lane = tid & 63, wid = tid >> 6; const int G = gridDim.x; unsigned char* ws = p.ws;
    const float* x = p.in[0]; const float* nw = p.in[1]; bf16_t* xw = (bf16_t*)(ws + OFF_XW); float* rstd = (float*)(ws + OFF_RSTD);
    f32x4 nv[4];
#pragma unroll
    for (int i = 0; i < 4; ++i) nv[i] = *(const f32x4*)(nw + i * 256 + lane * 4);
    for (int row = blockIdx.x * 8 + wid; row < MTOK; row += G * 8) {
        float ss = 0.f;
#pragma unroll
        for (int i = 0; i < 4; ++i) { const f32x4 v = *(const f32x4*)(x + (size_t)row * 1024 + i * 256 + lane * 4); ss += (v[0] * v[0] + v[1] * v[1]) + (v[2] * v[2] + v[3] * v[3]);
            const f32x4 t = v * nv[i]; u32x2 w; w.x = cvt_pk_bf16(t[0], t[1]); w.y = cvt_pk_bf16(t[2], t[3]); *(u32x2*)(xw + (size_t)row * 1024 + i * 256 + lane * 4) = w; }
#pragma unroll
        for (int o = 32; o >= 1; o >>= 1) ss += __shfl_xor(ss, o);
        if (lane == 0) rstd[row] = rsqrtf(ss * (1.0f / 1024.0f) + 1e-6f);
    }
    bf16_t* y2 = (bf16_t*)(ws + OFF_Y) + (size_t)2 * MTOK * 768;
    for (size_t i = (size_t)blockIdx.x * NTHR + tid; i < (size_t)MTOK * 32; i += (size_t)G * NTHR) { const size_t row = i >> 5, seg = i & 31; *(u32x4*)(y2 + row * 768 + 512 + seg * 8) = (u32x4){0u, 0u, 0u, 0u}; }
}

__device__ void mlstm_item(LAS unsigned char* lds, const Params& p, int layer, int item) {
    int tid_l = threadIdx.x; asm volatile("" : "+v"(tid_l)); const int tid = tid_l, lane = tid & 63, wid = __builtin_amdgcn_readfirstlane(tid >> 6), fr = lane & 15, fq = lane >> 4;
    const int es = item % 6, bh = item / 6, h = bh & 3, b = bh >> 2, e0 = es * 32;
    unsigned char* ws = p.ws;
    const bf16_t* aqk = (const bf16_t*)(ws + OFF_SG); bf16_t* y0 = (bf16_t*)(ws + OFF_Y); const float* small = (const float*)(ws + OFF_SMALL); float* sta = (float*)(ws + OFF_STA);
    const float* convw = p.in[3] + (size_t)layer * 4 * 1536; const float bi = p.in[4][layer * 8 + h], bfg = p.in[4][layer * 8 + 4 + h];
    LAS bf16_t* Qs = (LAS bf16_t*)lds; LAS bf16_t* Ks = Qs + 64 * 200; LAS bf16_t* KTs = Ks + 64 * 200; LAS bf16_t* VTs = KTs + 192 * 72; LAS bf16_t* VTw = VTs + 32 * 72;
    LAS bf16_t* Ss = VTw + 32 * 72; LAS bf16_t* CTs = Ss + 64 * 72; LAS float* fv = (LAS float*)(CTs + 32 * 200);
    LAS float* gk = fv; LAS float* ebm = fv + 64; LAS float* winter = fv + 128; LAS float* wk = fv + 192; LAS float* emt = fv + 256; LAS float* scal = fv + 320; LAS float* nv0 = fv + 328; LAS float* nv1 = nv0 + 192; LAS float* stx = nv1 + 192;
    for (int i = tid; i < 32 * 200; i += NTHR) CTs[i] = 0;
    for (int i = tid; i < 384; i += NTHR) nv0[i] = 0.f;
    f32x4 cacc[3];
#pragma unroll
    for (int i = 0; i < 3; ++i) cacc[i] = (f32x4){0.f, 0.f, 0.f, 0.f};
    float mstate = 0.f;
    const float kscale = 0.07216878364870322f;
    __syncthreads();
    for (int c = 0; c < 64; ++c) {
        const int row0 = b * SEQ + c * 64;
        LAS float* ncur = (c & 1) ? nv1 : nv0; LAS float* nnext = (c & 1) ? nv0 : nv1;
        if (wid == 0) {
            const float ip = small[(size_t)(row0 + lane) * 32 + h] + bi; const float fp = small[(size_t)(row0 + lane) * 32 + 4 + h] + bfg;
            const float bc = wave_scan_add(logsigmoidf_(fp), lane); const float g = ip - bc; const float cm = wave_scan_max(g, lane);
            const float mt = bc + fmaxf(mstate, cm);
            gk[lane] = g; ebm[lane] = bc - mt; winter[lane] = __expf(bc + mstate - mt); emt[lane] = __expf(-mt);
            const float bend = __shfl(bc, 63), gmax = __shfl(cm, 63); const float mnew = bend + fmaxf(mstate, gmax);
            wk[lane] = __expf(bend + g - mnew); if (lane == 0) scal[0] = __expf(bend + mstate - mnew);
            mstate = mnew;
        }
        for (int task = tid; task < 64 * 24; task += NTHR) {
            const int t = task / 24, d8 = task - t * 24; const int ch = h * 192 + d8 * 8;
            float aq[8], ak[8];
#pragma unroll
            for (int j = 0; j < 8; ++j) { aq[j] = 0.f; ak[j] = 0.f; }
#pragma unroll
            for (int tap = 0; tap < 4; ++tap) { const int tt = c * 64 + t - 3 + tap;
                if (tt >= 0) { const bf16_t* rp = aqk + (size_t)(b * SEQ + tt) * 1536 + ch; float rq[8], rk[8]; unpack8(*(const u32x4*)rp, rq); unpack8(*(const u32x4*)(rp + 768), rk);
                    const float* wq = convw + tap * 1536 + ch; const f32x4 q0 = *(const f32x4*)wq, q1 = *(const f32x4*)(wq + 4), k0 = *(const f32x4*)(wq + 768), k1 = *(const f32x4*)(wq + 772);
#pragma unroll
                    for (int j = 0; j < 4; ++j) { aq[j] += q0[j] * rq[j]; aq[4 + j] += q1[j] * rq[4 + j]; ak[j] += k0[j] * rk[j]; ak[4 + j] += k1[j] * rk[4 + j]; } } }
#pragma unroll
            for (int j = 0; j < 8; ++j) { aq[j] = siluf_(aq[j]); ak[j] = siluf_(ak[j]) * kscale; }
            *(LAS u32x4*)(Qs + t * 200 + d8 * 8) = pack8(aq); *(LAS u32x4*)(Ks + t * 200 + d8 * 8) = pack8(ak);
#pragma unroll
            for (int j = 0; j < 8; ++j) KTs[(d8 * 8 + j) * 72 + t] = f2bf(ak[j]);
        }
        float vreg[4]; const int vs = tid >> 3, ve = (tid & 7) * 4;
        { const u32x2 w = *(const u32x2*)(y0 + (size_t)(row0 + vs) * 768 + h * 192 + e0 + ve);
          vreg[0] = __uint_as_float(w.x << 16); vreg[1] = __uint_as_float(w.x & 0xffff0000u); vreg[2] = __uint_as_float(w.y << 16); vreg[3] = __uint_as_float(w.y & 0xffff0000u);
#pragma unroll
          for (int j = 0; j < 4; ++j) VTs[(ve + j) * 72 + vs] = f2bf(vreg[j]); }
        __syncthreads();
        { const float w = wk[vs];
#pragma unroll
          for (int j = 0; j < 4; ++j) VTw[(ve + j) * 72 + vs] = f2bf(vreg[j] * w); }
        { const int tr = wid >> 1;
#pragma unroll
          for (int q = 0; q < 2; ++q) { const int tc = (wid & 1) * 2 + q; f32x4 a = (f32x4){0.f, 0.f, 0.f, 0.f};
              if (tc <= tr) a = mma_tile<192>(Qs, 200, 16 * tr, Ks, 200, 16 * tc, a, lane);
              const int s = 16 * tc + fr; const float gs = gk[s];
#pragma unroll
              for (int r = 0; r < 4; ++r) { const int t = 16 * tr + 4 * fq + r; const float pv = (s <= t) ? a[r] * __expf(ebm[t] + gs) : 0.f; Ss[t * 72 + s] = f2bf(pv); } } }
        __syncthreads();
        float st1[4], st2[4];
        { const int tr = wid >> 1, ec = wid & 1;
          const int rr = lane >> 2, part = lane & 3; const int t = 16 * tr + rr; float rs = 0.f, qn = 0.f;
          { float f[8]; unpack8(*(const LAS u32x4*)(Ss + t * 72 + part * 16), f); rs += ((f[0] + f[1]) + (f[2] + f[3])) + ((f[4] + f[5]) + (f[6] + f[7]));
            unpack8(*(const LAS u32x4*)(Ss + t * 72 + part * 16 + 8), f); rs += ((f[0] + f[1]) + (f[2] + f[3])) + ((f[4] + f[5]) + (f[6] + f[7])); }
#pragma unroll
          for (int i = 0; i < 6; ++i) { float f[8]; unpack8(*(const LAS u32x4*)(Qs + t * 200 + part * 48 + i * 8), f);
#pragma unroll
              for (int j = 0; j < 8; ++j) qn += f[j] * ncur[part * 48 + i * 8 + j]; }
          rs += __shfl_xor(rs, 1); rs += __shfl_xor(rs, 2); qn += __shfl_xor(qn, 1); qn += __shfl_xor(qn, 2);
          const float den = rs + winter[t] * qn; const float dinv = 1.0f / fmaxf(fabsf(den), emt[t]);
          f32x4 apv = (f32x4){0.f, 0.f, 0.f, 0.f}, aqc = (f32x4){0.f, 0.f, 0.f, 0.f};
          apv = mma_tile<64>(Ss, 72, 16 * tr, VTs, 72, 16 * ec, apv, lane);
          aqc = mma_tile<192>(Qs, 200, 16 * tr, CTs, 200, 16 * ec, aqc, lane);
#pragma unroll
          for (int r = 0; r < 4; ++r) { const int tl = 4 * fq + r; const int tt = 16 * tr + tl; const float di = __shfl(dinv, tl * 4); const float o = (apv[r] + winter[tt] * aqc[r]) * di;
              y0[(size_t)(row0 + tt) * 768 + h * 192 + e0 + 16 * ec + fr] = f2bf(o);
              float s1 = o, s2 = o * o;
#pragma unroll
              for (int of = 1; of < 16; of <<= 1) { s1 += __shfl_xor(s1, of); s2 += __shfl_xor(s2, of); }
              if (fr == 0) { if (ec) { stx[tt * 2] = s1; stx[tt * 2 + 1] = s2; } else { st1[r] = s1; st2[r] = s2; } } } }
        { const float wp = scal[0];
#pragma unroll
          for (int i = 0; i < 3; ++i) { const int j = wid * 3 + i, er = j / 12, dc = j - er * 12; cacc[i] = cacc[i] * wp; cacc[i] = mma_tile<64>(VTw, 72, 16 * er, KTs, 72, 16 * dc, cacc[i], lane); }
          if (tid < 192) { float s = 0.f;
#pragma unroll
              for (int i = 0; i < 8; ++i) { float f[8]; unpack8(*(const LAS u32x4*)(KTs + tid * 72 + i * 8), f);
#pragma unroll
                  for (int j = 0; j < 8; ++j) s += f[j] * wk[i * 8 + j]; }
              nnext[tid] = wp * ncur[tid] + s; } }
        __syncthreads();
        if ((wid & 1) == 0 && fr == 0) {
#pragma unroll
            for (int r = 0; r < 4; ++r) { const int tt = 16 * (wid >> 1) + 4 * fq + r; *(f32x2v*)(sta + (((size_t)(row0 + tt) * 4 + h) * NSTAT + es) * 2) = (f32x2v){st1[r] + stx[tt * 2], st2[r] + stx[tt * 2 + 1]}; } }
#pragma unroll
        for (int i = 0; i < 3; ++i) { const int j = wid * 3 + i, er = j / 12, dc = j - er * 12;
#pragma unroll
            for (int r = 0; r < 4; ++r) CTs[(16 * er + 4 * fq + r) * 200 + 16 * dc + fr] = f2bf(cacc[i][r]); }
    }
    __syncthreads();
}

__device__ void gla_item(LAS unsigned char* lds, const Params& p, int layer, int item) {
    int tid_l = threadIdx.x; asm volatile("" : "+v"(tid_l)); const int tid = tid_l, lane = tid & 63, wid = __builtin_amdgcn_readfirstlane(tid >> 6), fr = lane & 15, fq = lane >> 4;
    const int es = item % 6, bh = item / 6, h = bh & 3, b = bh >> 2, e0 = es * 32;
    unsigned char* ws = p.ws;
    const bf16_t* bqk = (const bf16_t*)(ws + OFF_SG) + (size_t)MTOK * 1536; bf16_t* y1 = (bf16_t*)(ws + OFF_Y) + (size_t)MTOK * 768; const float* small = (const float*)(ws + OFF_SMALL); float* stb = (float*)(ws + OFF_STB);
    const float* walpha = p.in[6] + (size_t)layer * 16 * 384; const float* balpha = p.in[7] + (size_t)layer * 384;
    LAS bf16_t* Qs = (LAS bf16_t*)lds; LAS bf16_t* Ks = Qs + 64 * 104; LAS bf16_t* KTs = Ks + 64 * 104; LAS bf16_t* VTs = KTs + 96 * 72; LAS bf16_t* Ss = VTs + 32 * 72; LAS bf16_t* STs = Ss + 64 * 72;
    LAS float* Bc = (LAS float*)(STs + 32 * 104); LAS float* BAs = Bc + 64 * 97; LAS float* stx = BAs + 64 * 16;
    for (int i = tid; i < 32 * 104; i += NTHR) STs[i] = 0;
    f32x4 sacc[2]; sacc[0] = (f32x4){0.f, 0.f, 0.f, 0.f}; sacc[1] = (f32x4){0.f, 0.f, 0.f, 0.f};
    const int gd = tid % 96, gtq = tid / 96; float wal[16]; float bal = 0.f;
    if (tid < 384) {
#pragma unroll
        for (int r = 0; r < 16; ++r) wal[r] = walpha[r * 384 + h * 96 + gd];
        bal = balpha[h * 96 + gd]; }
    const float qscale = 0.10206207261596575f;
    __syncthreads();
    for (int c = 0; c < 64; ++c) {
        const int row0 = b * SEQ + c * 64;
        for (int i = tid; i < 64 * 4; i += NTHR) { const int t = i >> 2, q = i & 3; *(LAS f32x4*)(BAs + t * 16 + q * 4) = *(const f32x4*)(small + (size_t)(row0 + t) * 32 + 8 + q * 4); }
        __syncthreads();
        if (tid < 384) {
#pragma unroll 4
            for (int i = 0; i < 16; ++i) { const int t = gtq * 16 + i; float z = bal;
#pragma unroll
                for (int r = 0; r < 16; ++r) z += BAs[t * 16 + r] * wal[r];
                Bc[t * 97 + gd] = logsigmoidf_(z) * (1.0f / 16.0f); } }
        __syncthreads();
        for (int i = 0; i < 12; ++i) { const int d = wid * 12 + i; const float v = wave_scan_add(Bc[lane * 97 + d], lane); Bc[lane * 97 + d] = v; }
        __syncthreads();
        for (int task = tid; task < 64 * 12; task += NTHR) {
            const int t = task / 12, d8 = task - t * 12; const bf16_t* rp = bqk + (size_t)(row0 + t) * 768 + h * 96 + d8 * 8; float q[8], k[8], k2[8];
            unpack8(*(const u32x4*)rp, q); unpack8(*(const u32x4*)(rp + 384), k);
#pragma unroll
            for (int j = 0; j < 8; ++j) { const float bc = Bc[t * 97 + d8 * 8 + j], bl = Bc[63 * 97 + d8 * 8 + j]; q[j] = q[j] * qscale * __expf(bc); k2[j] = k[j] * __expf(bl - bc); k[j] = k[j] * __expf(-bc); }
            *(LAS u32x4*)(Qs + t * 104 + d8 * 8) = pack8(q); *(LAS u32x4*)(Ks + t * 104 + d8 * 8) = pack8(k);
#pragma unroll
            for (int j = 0; j < 8; ++j) KTs[(d8 * 8 + j) * 72 + t] = f2bf(k2[j]);
        }
        { const int vs = tid >> 3, ve = (tid & 7) * 4; const u32x2 w = *(const u32x2*)(y1 + (size_t)(row0 + vs) * 768 + h * 192 + e0 + ve);
          VTs[(ve + 0) * 72 + vs] = (bf16_t)(w.x & 0xffffu); VTs[(ve + 1) * 72 + vs] = (bf16_t)(w.x >> 16); VTs[(ve + 2) * 72 + vs] = (bf16_t)(w.y & 0xffffu); VTs[(ve + 3) * 72 + vs] = (bf16_t)(w.y >> 16); }
        __syncthreads();
        { const int tr = wid >> 1;
#pragma unroll
          for (int q = 0; q < 2; ++q) { const int tc = (wid & 1) * 2 + q; f32x4 a = (f32x4){0.f, 0.f, 0.f, 0.f};
              if (tc <= tr) a = mma_tile<96>(Qs, 104, 16 * tr, Ks, 104, 16 * tc, a, lane);
              const int s = 16 * tc + fr;
#pragma unroll
              for (int r = 0; r < 4; ++r) { const int t = 16 * tr + 4 * fq + r; Ss[t * 72 + s] = f2bf((s <= t) ? a[r] : 0.f); } } }
        __syncthreads();
        float st2[4];
        { const int tr = wid >> 1, ec = wid & 1; f32x4 o = (f32x4){0.f, 0.f, 0.f, 0.f};
          o = mma_tile<64>(Ss, 72, 16 * tr, VTs, 72, 16 * ec, o, lane);
          o = mma_tile<96>(Qs, 104, 16 * tr, STs, 104, 16 * ec, o, lane);
#pragma unroll
          for (int r = 0; r < 4; ++r) { const int tt = 16 * tr + 4 * fq + r; y1[(size_t)(row0 + tt) * 768 + h * 192 + e0 + 16 * ec + fr] = f2bf(o[r]);
              float s2 = o[r] * o[r];
#pragma unroll
              for (int of = 1; of < 16; of <<= 1) s2 += __shfl_xor(s2, of);
              if (fr == 0) { if (ec) stx[tt] = s2; else st2[r] = s2; } } }
        if (wid < 6) { const float dec = __expf(Bc[63 * 97 + 16 * wid + fr]);
#pragma unroll
            for (int er = 0; er < 2; ++er) { sacc[er] = sacc[er] * dec; sacc[er] = mma_tile<64>(VTs, 72, 16 * er, KTs, 72, 16 * wid, sacc[er], lane); } }
        __syncthreads();
        if ((wid & 1) == 0 && fr == 0) {
#pragma unroll
            for (int r = 0; r < 4; ++r) { const int tt = 16 * (wid >> 1) + 4 * fq + r; stb[((size_t)(row0 + tt) * 4 + h) * NSTAT + es] = st2[r] + stx[tt]; } }
        if (wid < 6) {
#pragma unroll
            for (int er = 0; er < 2; ++er)
#pragma unroll
                for (int r = 0; r < 4; ++r) STs[(16 * er + 4 * fq + r) * 104 + 16 * wid + fr] = f2bf(sacc[er][r]); }
    }
    __syncthreads();
}

__device__ __forceinline__ void cmul(float ar, float ai, float br, float bi, float& cr, float& ci) { cr = ar * br - ai * bi; ci = ar * bi + ai * br; }
__device__ void s5_item(LAS unsigned char* lds, const Params& p, int layer, int item) {
    int tid_l = threadIdx.x; asm volatile("" : "+v"(tid_l)); const int tid = tid_l, lane = tid & 63, wid = __builtin_amdgcn_readfirstlane(tid >> 6), fr = lane & 15, fq = lane >> 4;
    const int g = item & 31, b = item >> 5; unsigned char* ws = p.ws;
    bf16_t* cu = (bf16_t*)(ws + OFF_CU);
    const float* lam_re = p.in[9] + (size_t)layer * 2048 + g * 64; const float* lam_im = p.in[10] + (size_t)layer * 2048 + g * 64; const float ldt = p.in[11][layer * 32 + g];
    const float* Bre = p.in[12] + ((size_t)layer * 32 + g) * 1024; const float* Bim = p.in[13] + ((size_t)layer * 32 + g) * 1024;
    const float* Cre = p.in[14] + ((size_t)layer * 32 + g) * 1024; const float* Cim = p.in[15] + ((size_t)layer * 32 + g) * 1024;
    const float dsk = p.in[16][layer * 512 + g * 16 + fr];
    LAS float* BU = (LAS float*)(lds + wid * 12288);
    LAS bf16_t* Xs = (LAS bf16_t*)(lds + wid * 12288 + 8192);
    LAS float* Es = (LAS float*)(lds + 8 * 12288);
    const float dt = __expf(ldt);
    float are, aim;
    { const float lr = fminf(lam_re[lane], -1e-4f), li = lam_im[lane]; const float mag = __expf(lr * dt); are = mag * cosf(li * dt); aim = mag * sinf(li * dt); }
    bf16x8 bbop[8];
#pragma unroll
    for (int ct = 0; ct < 8; ++ct) { const int pp = 16 * ct + fr, ps = pp >> 1, cc = pp & 1; float f[8];
        const float lr = fminf(lam_re[ps], -1e-4f), li = lam_im[ps]; const float mag = __expf(lr * dt); const float abr = mag * cosf(li * dt), abi = mag * sinf(li * dt);
        const float nr = abr - 1.0f, den = lr * lr + li * li; const float cre = (nr * lr + abi * li) / den, cim = (abi * lr - nr * li) / den;
#pragma unroll
        for (int j = 0; j < 8; ++j) { float v = 0.f; if (fq < 2) { const float br = Bre[ps * 16 + 8 * fq + j], bi = Bim[ps * 16 + 8 * fq + j]; v = cc ? (cre * bi + cim * br) : (cre * br - cim * bi); } f[j] = v; }
        const u32x4 w = pack8(f); bbop[ct] = *(const bf16x8*)&w; }
    bf16x8 cmop[4];
#pragma unroll
    for (int ks = 0; ks < 4; ++ks) { float f[8];
#pragma unroll
        for (int j = 0; j < 8; ++j) { const int pp = 32 * ks + 8 * fq + j, ps = pp >> 1; f[j] = (pp & 1) ? -Cim[fr * 64 + ps] : Cre[fr * 64 + ps]; }
        const u32x4 w = pack8(f); cmop[ks] = *(const bf16x8*)&w; }
    const int seg0 = b * SEQ + wid * 512;
    float xr = 0.f, xi = 0.f;
    for (int pass = 0; pass < 2; ++pass) {
        for (int tile = 0; tile < 32; ++tile) {
            const int r0 = seg0 + tile * 16;
            bf16x8 aop; { u32x4 w = (u32x4){0u, 0u, 0u, 0u}; if (fq < 2) w = *(const u32x4*)(cu + (size_t)(r0 + fr) * 512 + g * 16 + 8 * fq); aop = *(const bf16x8*)&w; }
#pragma unroll
            for (int ct = 0; ct < 8; ++ct) { f32x4 a = (f32x4){0.f, 0.f, 0.f, 0.f}; a = __builtin_amdgcn_mfma_f32_16x16x32_bf16(aop, bbop[ct], a, 0, 0, 0);
#pragma unroll
                for (int r = 0; r < 4; ++r) BU[(4 * fq + r) * 128 + 16 * ct + fr] = a[r]; }
#pragma unroll
            for (int t = 0; t < 16; ++t) { const f32x2v bu = *(const LAS f32x2v*)(BU + t * 128 + 2 * lane); const float nr = are * xr - aim * xi + bu.x, ni = are * xi + aim * xr + bu.y; xr = nr; xi = ni;
                if (pass) *(LAS unsigned*)(Xs + t * 128 + 2 * lane) = cvt_pk_bf16(xr, xi); }
            if (pass) {
                f32x4 y = (f32x4){0.f, 0.f, 0.f, 0.f};
#pragma unroll
                for (int ks = 0; ks < 4; ++ks) { const bf16x8 xa = *(const LAS bf16x8*)(Xs + fr * 128 + 32 * ks + 8 * fq); y = __builtin_amdgcn_mfma_f32_16x16x32_bf16(xa, cmop[ks], y, 0, 0, 0); }
#pragma unroll
                for (int r = 0; r < 4; ++r) { bf16_t* up = cu + (size_t)(r0 + 4 * fq + r) * 512 + g * 16 + fr; const float uv = bf2f(*up); *up = f2bf(geluf_(y[r] + dsk * uv)); }
            }
        }
        if (pass == 0) {
            Es[(wid * 64 + lane) * 2] = xr; Es[(wid * 64 + lane) * 2 + 1] = xi;
            __syncthreads();
            float pr = are, pi = aim;
#pragma unroll
            for (int i = 0; i < 9; ++i) { float tr, ti; cmul(pr, pi, pr, pi, tr, ti); pr = tr; pi = ti; }
            xr = 0.f; xi = 0.f;
            for (int w = 0; w < wid; ++w) { float tr, ti; cmul(pr, pi, xr, xi, tr, ti); xr = tr + Es[(w * 64 + lane) * 2]; xi = ti + Es[(w * 64 + lane) * 2 + 1]; }
        }
    }
    __syncthreads();
}

__global__ void __launch_bounds__(NTHR, 2) hybrid_fwd(Params p) {
    extern __shared__ __attribute__((aligned(16))) unsigned char lds_raw[];
    LAS unsigned char* lds = (LAS unsigned char*)lds_raw;
    cg::grid_group grid = cg::this_grid();
    const int G = gridDim.x, c = blockIdx.x; unsigned char* ws = p.ws;
    bf16_t* W1A = (bf16_t*)(ws + OFF_W1A); bf16_t* W1B = (bf16_t*)(ws + OFF_W1B); bf16_t* WGLU = (bf16_t*)(ws + OFF_WGLU); bf16_t* WBR = (bf16_t*)(ws + OFF_WBR); bf16_t* WOUT = (bf16_t*)(ws + OFF_WOUT);
    bf16_t* XW = (bf16_t*)(ws + OFF_XW); float* RSS = (float*)(ws + OFF_RSS); bf16_t* Y = (bf16_t*)(ws + OFF_Y); bf16_t* SG = (bf16_t*)(ws + OFF_SG);
    bf16_t* CU = (bf16_t*)(ws + OFF_CU); bf16_t* SCZ = (bf16_t*)(ws + OFF_SCZ); float* SMALL = (float*)(ws + OFF_SMALL); bf16_t* MERGED = (bf16_t*)(ws + OFF_MERGED);
    float* STA = (float*)(ws + OFF_STA); float* STB = (float*)(ws + OFF_STB); float* RSTD = (float*)(ws + OFF_RSTD);

    phase_prologue_x(p);
    for (int layer = 0; layer < 2; ++layer) {
        phase_convert(lds, p, layer);
        grid.sync();
        { pg8::Gemm g{XW, W1A, MTOK, N1A, 1024}; pg8::StaticOrder S; S.init(MTOK, N1A, G, c);
          EpiG1a E{RSTD, SG, SG + (size_t)MTOK * 1536, Y, Y + (size_t)MTOK * 768, CU, SCZ, SMALL};
          pg8::gemm_phase<EpiG1a, pg8::StaticOrder, false>(lds, g, S, E, nullptr); }
        grid.sync();
        for (int it = c; it < 256; it += G) {
            if (it < 96) mlstm_item(lds, p, layer, it);
            else if (it < 192) gla_item(lds, p, layer, it - 96);
            else { s5_item(lds, p, layer, it - 192); s5_item(lds, p, layer, it - 192 + 64); }
        }
        grid.sync();
        { pg8::Gemm g{XW, W1B, MTOK, N1B, 1024}; pg8::StaticOrder S; S.init(MTOK, N1B, G, c);
          EpiG1b E{RSTD, Y, Y + (size_t)MTOK * 768, SG, STA, STB, p.in[5] + (size_t)layer * 768, p.in[8] + (size_t)layer * 768};
          pg8::gemm_phase<EpiG1b, pg8::StaticOrder, false>(lds, g, S, E, nullptr); }
        { const bool split = (G == 256); const int g2G = split ? 128 : G, g2c = split ? c - 128 : c;
          if (g2c >= 0) { pg8::Gemm g{CU, WGLU, MTOK, 512, 512}; pg8::StaticOrder S; S.init(MTOK, 512, g2G, g2c);
              EpiG2 E{CU, SCZ, Y + (size_t)2 * MTOK * 768};
              pg8::gemm_phase<EpiG2, pg8::StaticOrder, false>(lds, g, S, E, nullptr); } }
        grid.sync();
        { pg8::Gemm g{Y, WBR, 3 * MTOK, 3 * 1024, 768}; BranchOrder S{G, c}; EpiG3 E{SG, MERGED};
          pg8::gemm_phase<EpiG3, BranchOrder, false>(lds, g, S, E, nullptr); }
        grid.sync();
        { pg8::Gemm g{MERGED, WOUT, MTOK, 1024, 1024}; pg8::StaticOrder S; S.init(MTOK, 1024, G, c);
          EpiG4 E{layer == 0 ? p.in[0] : p.out, p.out, XW, layer == 0 ? p.in[1] + 1024 : p.in[22], RSS, layer == 0 ? 1 : 0};
          pg8::gemm_phase<EpiG4, pg8::StaticOrder, false>(lds, g, S, E, nullptr); }
        grid.sync();
    }
    { const int tid = threadIdx.x, lane = tid & 63, wid = tid >> 6; const float* fn = p.in[22];
      f32x4 nv[4];
#pragma unroll
      for (int i = 0; i < 4; ++i) nv[i] = *(const f32x4*)(fn + i * 256 + lane * 4);
      for (int row = c * 8 + wid; row < MTOK; row += G * 8) { const float rs = row_rstd(RSS, row);
#pragma unroll
          for (int i = 0; i < 4; ++i) { float* op = p.out + (size_t)row * 1024 + i * 256 + lane * 4; const f32x4 v = *(const f32x4*)op; *(f32x4*)op = v * rs * nv[i]; } } }
}

extern "C" void kernel_launch(void* const* d_in, const int* in_sizes, int n_in, void* d_out, int out_size, void* d_ws, size_t ws_size, hipStream_t stream) {
    static int grid_blocks = 0;
    if (grid_blocks == 0) {
        if (n_in != 23 || ws_size < WS_END) { fprintf(stderr, "kernel_launch: need 23 inputs and %zu bytes of workspace (got %d, %zu)\n", (size_t)WS_END, n_in, ws_size); grid_blocks = -1; return; }
        int dev = 0, cus = 0, per_cu = 0;
        hipGetDevice(&dev); hipDeviceGetAttribute(&cus, hipDeviceAttributeMultiprocessorCount, dev);
        if (hipFuncSetAttribute((const void*)hybrid_fwd, hipFuncAttributeMaxDynamicSharedMemorySize, LDS_BYTES) != hipSuccess) { fprintf(stderr, "kernel_launch: hipFuncSetAttribute failed\n"); grid_blocks = -1; return; }
        if (hipOccupancyMaxActiveBlocksPerMultiprocessor(&per_cu, (const void*)hybrid_fwd, NTHR, LDS_BYTES) != hipSuccess || per_cu < 1) per_cu = 1;
        (void)hipGetLastError();
        grid_blocks = cus * 1;
    }
    if (grid_blocks < 0) return;
    Params p{};
    for (int i = 0; i < 23; ++i) p.in[i] = (const float*)d_in[i];
    p.out = (float*)d_out; p.ws = (unsigned char*)d_ws;
    void* args[] = {&p};
    hipError_t e = hipLaunchCooperativeKernel((const void*)hybrid_fwd, dim3(grid_blocks), dim3(NTHR), args, LDS_BYTES, stream);
    if (e != hipSuccess) fprintf(stderr, "cooperative launch failed: %s (grid %d)\n", hipGetErrorString(e), grid_blocks);
}
```

```cpp
#include <hip/hip_runtime.h>
#include <hip/hip_cooperative_groups.h>
#include <cstdio>
namespace cg = cooperative_groups;
namespace pg8 {
#define PG8_LAS __attribute__((address_space(3)))
typedef unsigned short bf16_t;
typedef short bf16x8 __attribute__((ext_vector_type(8)));
typedef float f32x4 __attribute__((ext_vector_type(4)));
typedef unsigned u32x4 __attribute__((ext_vector_type(4)));
constexpr int BM = 256, BK = 64, HALF = 128, HTB = HALF * BK * 2  , STAGE_BYTES = 8 * HTB, NXCD = 8, WGM = 8;

__host__ __device__ __forceinline__ int lds_byte(int r, int c) { const int st = (r >> 4) * 2 + (c >> 5), rr = r & 15, cc = c & 31, ob = rr * 64 + cc * 2; return st * 1024 + (ob ^ (((ob >> 9) & 1) << 5)); }
__host__ __device__ __forceinline__ void stage_rc(int b, int& R, int& C) { const int st = b / 1024, sb = b % 1024, swz = sb ^ (((sb >> 9) & 1) << 5); R = (st >> 1) * 16 + swz / 64; C = (st & 1) * 32 + (swz % 64) / 2; }
__host__ __device__ __forceinline__ int perm32(int rho) { const int n = rho >> 4, i = rho & 15; return 8 * (i >> 2) + 4 * n + (i & 3); }

struct Unit { int pm, pn; };
struct Gemm { const bf16_t* A; const bf16_t* Bt; int M, N, K; };

struct StaticOrder {
    int nM, nN, nwg, G, c;
    __host__ __device__ void init(int M, int N, int G_, int c_) { nM = M / BM; nN = N / BM; nwg = nM * nN; G = G_; c = c_; }
    __host__ __device__ bool next(int i, Unit& u) const {
        const long L = (long)i * G + c; if (L >= nwg) return false;
        int wgid = (int)L; { const int q = nwg / NXCD, r = nwg % NXCD, xcd = wgid % NXCD, off = wgid / NXCD; wgid = (xcd < r ? xcd * (q + 1) : r * (q + 1) + (xcd - r) * q) + off; }
        const int nig = WGM * nN, gid = wgid / nig, fm = gid * WGM, gsz = (nM - fm) < WGM ? (nM - fm) : WGM;
        u.pm = fm + ((wgid % nig) % gsz); u.pn = (wgid % nig) / gsz; return true;
    }
    __device__ __forceinline__ void a_ready(const Unit&) const {}
    __device__ __forceinline__ void done(const Unit&) const {}
};
typedef float f32x2c __attribute__((ext_vector_type(2)));
typedef __bf16 bf16x2c __attribute__((ext_vector_type(2)));
__device__ __forceinline__ unsigned cvt_pk_bf16(float lo, float hi) { const f32x2c v = {lo, hi}; const bf16x2c r = __builtin_convertvector(v, bf16x2c); return __builtin_bit_cast(unsigned, r); }
typedef float f32x2 __attribute__((ext_vector_type(2)));
template <class Epi, class Sched, bool STAMP = false>
__device__ __forceinline__ void gemm_phase(PG8_LAS unsigned char* lds, const Gemm g, const Sched& S, const Epi& E, unsigned long long* stamps) {
    int tid_l = threadIdx.x; asm volatile("" : "+v"(tid_l)); const int tid = tid_l, wid = __builtin_amdgcn_readfirstlane(tid >> 6), lane = tid & 63, wr = wid >> 2, wc = wid & 3, fr = lane & 15, fq = lane >> 4;
    const int K = g.K, nt = K / BK;
    int ts_lo = 0, ts_hi = 0, nts = 0; const unsigned long long rt_entry = STAMP ? (unsigned long long)wall_clock64() : 0ull;
#define PG8_STAMP() do { if (STAMP && wid == 0 && nts < 64) { const unsigned long long _c = (unsigned long long)clock64(); \
        ts_lo = (lane == nts) ? (int)(unsigned)_c : ts_lo; ts_hi = (lane == nts) ? (int)(unsigned)(_c >> 32) : ts_hi; ++nts; } } while (0)
    PG8_STAMP();
    unsigned voffA[2], voffB[2];
#pragma unroll
    for (int i = 0; i < 2; ++i) { int R, C; stage_rc(tid * 16 + i * 8192, R, C); const int Rb = Epi::PERM ? ((R & ~31) + perm32(R & 31)) : R;
        voffA[i] = (unsigned)(R * K + C) * 2u; voffB[i] = (unsigned)(Rb * K + C) * 2u; }
    const size_t kstep = (size_t)(BK * 2);
    const size_t hstep = (size_t)HALF * K * 2;
    const size_t tstep = 2 * hstep;
    const unsigned ldsw = (unsigned)wid * 1024u;
    const int aoff = lds_byte(wr * 64 + fr, fq * 8), boff = lds_byte(wc * 32 + fr, fq * 8);
#define PG8_SA(b, h) (((b) * 2 + (h)) * HTB)
#define PG8_SB(b, h) ((4 + (b) * 2 + (h)) * HTB)
#define PG8_STAGE(bufoff, gbase, voff) do { _Pragma("unroll") for (int _i = 0; _i < 2; ++_i) \
        __builtin_amdgcn_global_load_lds((const unsigned*)((const char*)(gbase) + (voff)[_i]), (PG8_LAS unsigned*)(lds + (bufoff) + ldsw + _i * 8192), 16, 0, 0); } while (0)
#define PG8_LDA(dst, b, h) do { _Pragma("unroll") for (int m = 0; m < 4; ++m) _Pragma("unroll") for (int k = 0; k < 2; ++k) dst[m][k] = *(const PG8_LAS bf16x8*)(lds + PG8_SA(b, h) + aoff + m * 2048 + k * 1024); } while (0)
#define PG8_LDB(dst, b, h) do { _Pragma("unroll") for (int n = 0; n < 2; ++n) _Pragma("unroll") for (int k = 0; k < 2; ++k) dst[n][k] = *(const PG8_LAS bf16x8*)(lds + PG8_SB(b, h) + boff + n * 2048 + k * 1024); } while (0)
#define PG8_MMA(ai, bj, At, Bt) do { __builtin_amdgcn_s_setprio(1); _Pragma("unroll") for (int m = 0; m < 4; ++m) _Pragma("unroll") for (int n = 0; n < 2; ++n) _Pragma("unroll") for (int k = 0; k < 2; ++k) \
        acc[ai][bj][m][n] = __builtin_amdgcn_mfma_f32_16x16x32_bf16(Bt[n][k], At[m][k], acc[ai][bj][m][n], 0, 0, 0); __builtin_amdgcn_s_setprio(0); } while (0)
#define PG8_WAIT_V(n) asm volatile("s_waitcnt vmcnt(" #n ")" ::: "memory")
#define PG8_WAIT_L(n) asm volatile("s_waitcnt lgkmcnt(" #n ")" ::: "memory")
#define PG8_BAR __builtin_amdgcn_s_barrier()
#define PG8_SCHED __builtin_amdgcn_sched_barrier(0)
    Unit cur, nxt; int ui = 0;
    if (!S.next(0, cur)) return;
    f32x4 acc[2][2][4][2];
#pragma unroll
    for (int a = 0; a < 2; ++a)
#pragma unroll
        for (int b = 0; b < 2; ++b)
#pragma unroll
            for (int m = 0; m < 4; ++m)
#pragma unroll
                for (int n = 0; n < 2; ++n) acc[a][b][m][n] = (f32x4){0.f, 0.f, 0.f, 0.f};
    bf16x8 At[4][2], B0[2][2], B1[2][2];
    const char* cA = (const char*)g.A + (size_t)cur.pm * tstep; const char* cB = (const char*)g.Bt + (size_t)cur.pn * tstep;
    S.a_ready(cur);
    PG8_STAGE(PG8_SB(0, 0), cB, voffB); PG8_STAGE(PG8_SA(0, 0), cA, voffA); PG8_STAGE(PG8_SB(0, 1), cB + hstep, voffB); PG8_STAGE(PG8_SA(0, 1), cA + hstep, voffA);
    if (wr == 1) PG8_BAR;
    PG8_WAIT_V(4); PG8_BAR;
    PG8_STAGE(PG8_SB(1, 0), cB + kstep, voffB); PG8_STAGE(PG8_SA(1, 0), cA + kstep, voffA); PG8_STAGE(PG8_SB(1, 1), cB + hstep + kstep, voffB);
    PG8_WAIT_V(6); PG8_BAR;
    PG8_STAMP();
    for (;;) {
        const bool has_next = S.next(ui + 1, nxt);
        const char* nA = has_next ? (const char*)g.A + (size_t)nxt.pm * tstep : cA; const char* nB = has_next ? (const char*)g.Bt + (size_t)nxt.pn * tstep : cB;
        for (int t = 0; t < nt; t += 2) {
            const bool last = (t == nt - 2);
            const char* a1 = cA + (size_t)(t + 1) * kstep;
            const char* a2 = last ? nA : cA + (size_t)(t + 2) * kstep; const char* b2 = last ? nB : cB + (size_t)(t + 2) * kstep;
            const char* a3 = a2 + kstep; const char* b3 = b2 + kstep;
            if (last && has_next) S.a_ready(nxt);
            PG8_LDB(B0, 0, 0); PG8_SCHED; PG8_LDA(At, 0, 0); PG8_STAGE(PG8_SA(1, 1), a1 + hstep, voffA);
            PG8_WAIT_L(8); PG8_BAR; PG8_WAIT_L(0); PG8_MMA(0, 0, At, B0); PG8_BAR; PG8_SCHED;
            PG8_LDB(B1, 0, 1); PG8_STAGE(PG8_SB(0, 0), b2, voffB);
            PG8_BAR; PG8_WAIT_L(0); PG8_MMA(0, 1, At, B1); PG8_BAR;
            PG8_LDA(At, 0, 1); PG8_STAGE(PG8_SA(0, 0), a2, voffA);
            PG8_BAR; PG8_WAIT_L(0); PG8_MMA(1, 0, At, B0); PG8_BAR; PG8_SCHED;
            PG8_STAGE(PG8_SB(0, 1), b2 + hstep, voffB);
            PG8_WAIT_V(6); PG8_BAR; PG8_MMA(1, 1, At, B1); PG8_BAR;
            PG8_LDB(B0, 1, 0); PG8_SCHED; PG8_LDA(At, 1, 0); PG8_STAGE(PG8_SA(0, 1), a2 + hstep, voffA);
            PG8_WAIT_L(8); PG8_BAR; PG8_WAIT_L(0); PG8_MMA(0, 0, At, B0); PG8_BAR; PG8_SCHED;
            PG8_LDB(B1, 1, 1); PG8_STAGE(PG8_SB(1, 0), b3, voffB);
            PG8_BAR; PG8_WAIT_L(0); PG8_MMA(0, 1, At, B1); PG8_BAR;
            PG8_LDA(At, 1, 1); PG8_STAGE(PG8_SA(1, 0), a3, voffA);
            PG8_BAR; PG8_WAIT_L(0); PG8_MMA(1, 0, At, B0); PG8_BAR; PG8_SCHED;
            PG8_STAGE(PG8_SB(1, 1), b3 + hstep, voffB);
            PG8_WAIT_V(6); PG8_BAR; PG8_MMA(1, 1, At, B1); PG8_BAR;
        }
        PG8_STAMP();
        if constexpr (!Epi::AFTER_DRAIN) { E(acc, cur, wr, wc, fr, fq); S.done(cur); }
        PG8_STAMP();
        if (!has_next) break;
#pragma unroll
        for (int a = 0; a < 2; ++a)
#pragma unroll
            for (int b = 0; b < 2; ++b)
#pragma unroll
                for (int m = 0; m < 4; ++m)
#pragma unroll
                    for (int n = 0; n < 2; ++n) acc[a][b][m][n] = (f32x4){0.f, 0.f, 0.f, 0.f};
        cur = nxt; cA = nA; cB = nB; ++ui;
    }
    PG8_WAIT_V(0);
    if (wr == 0) PG8_BAR;
    PG8_BAR;
    if constexpr (Epi::AFTER_DRAIN) { E.fused(acc, cur, wr, wc, fr, fq, lds, wid, lane); S.done(cur); }
    PG8_STAMP();
    if (STAMP && wid == 0) { stamps[lane] = lane < nts ? (((unsigned long long)(unsigned)ts_hi << 32) | (unsigned)ts_lo) : 0ull;
        if (lane == 62) stamps[62] = rt_entry; if (lane == 63) stamps[63] = (unsigned long long)wall_clock64(); }
#undef PG8_STAMP
#undef PG8_SA
#undef PG8_SB
#undef PG8_STAGE
#undef PG8_LDA
#undef PG8_LDB
#undef PG8_MMA
#undef PG8_WAIT_V
#undef PG8_WAIT_L
#undef PG8_BAR
#undef PG8_SCHED
}
}

#define LAS __attribute__((address_space(3)))
using pg8::bf16_t; using pg8::bf16x8; using pg8::f32x4; using pg8::u32x4; using pg8::Unit; using pg8::cvt_pk_bf16;
typedef unsigned u32x2 __attribute__((ext_vector_type(2)));
typedef float f32x2v __attribute__((ext_vector_type(2)));

constexpr int MTOK = 16384, DM = 1024, SEQ = 4096;
constexpr int NTHR = 512;
constexpr int LDS_BYTES = 131072 + 16;
constexpr int N1A = 5120, N1B = 5376;
constexpr int NSTAT = 6;
constexpr int NSTA = 2;

constexpr size_t OFF_W1A = 0;
constexpr size_t OFF_W1B = OFF_W1A + (size_t)N1A * 1024 * 2;
constexpr size_t OFF_WGLU = OFF_W1B + (size_t)N1B * 1024 * 2;
constexpr size_t OFF_WBR = OFF_WGLU + (size_t)512 * 512 * 2;
constexpr size_t OFF_WOUT = OFF_WBR + (size_t)3 * 1024 * 768 * 2;
constexpr size_t OFF_XW = OFF_WOUT + (size_t)1024 * 1024 * 2;
constexpr size_t OFF_RSS = OFF_XW + (size_t)MTOK * 1024 * 2;
constexpr size_t OFF_Y = OFF_RSS + (size_t)MTOK * 16 * 4;
constexpr size_t OFF_SG = OFF_Y + (size_t)3 * MTOK * 768 * 2;
constexpr size_t OFF_CU = OFF_SG + (size_t)MTOK * 3072 * 2;
constexpr size_t OFF_SCZ = OFF_CU + (size_t)MTOK * 512 * 2;
constexpr size_t OFF_SMALL = OFF_SCZ + (size_t)MTOK * 512 * 2;
constexpr size_t OFF_MERGED = OFF_SMALL + (size_t)MTOK * 32 * 4;
constexpr size_t OFF_STA = OFF_MERGED + (size_t)MTOK * 1024 * 2;
constexpr size_t OFF_STB = OFF_STA + (size_t)MTOK * 4 * NSTAT * 2 * 4;
constexpr size_t OFF_RSTD = OFF_STB + (size_t)MTOK * 4 * NSTAT * 4;
constexpr size_t OFF_BAR = OFF_RSTD + (size_t)MTOK * 4;
constexpr size_t BAR_BYTES = 16384;
constexpr size_t OFF_VG = OFF_BAR + BAR_BYTES;
constexpr int VGC = 42;
constexpr size_t WS_END = OFF_VG + (size_t)4 * VGC * 4 * 64 * 192 * 2;

struct Params { const float* in[23]; float* out; unsigned char* ws; };

__device__ __forceinline__ float bf2f(unsigned v) { return __uint_as_float(v << 16); }
__device__ __forceinline__ bf16_t f2bf(float f) { unsigned u = __float_as_uint(f); u += 0x7FFFu + ((u >> 16) & 1u); return (bf16_t)(u >> 16); }
__device__ __forceinline__ float sigmoidf_(float x) { return __builtin_amdgcn_rcpf(1.0f + __expf(-x)); }
__device__ __forceinline__ float siluf_(float x) { return x * sigmoidf_(x); }
__device__ __forceinline__ float logsigmoidf_(float x) { return fminf(x, 0.0f) - log1pf(__expf(-fabsf(x))); }
__device__ __forceinline__ float geluf_(float x) { const float u = 0.7978845608028654f * (x + 0.044715f * x * x * x); const float t = 1.0f - 2.0f * __builtin_amdgcn_rcpf(1.0f + __expf(2.0f * u)); return 0.5f * x * (1.0f + t); }
__device__ __forceinline__ void unpack8(const u32x4 w, float (&f)[8]) {
    f[0] = __uint_as_float(w.x << 16); f[1] = __uint_as_float(w.x & 0xffff0000u); f[2] = __uint_as_float(w.y << 16); f[3] = __uint_as_float(w.y & 0xffff0000u);
    f[4] = __uint_as_float(w.z << 16); f[5] = __uint_as_float(w.z & 0xffff0000u); f[6] = __uint_as_float(w.w << 16); f[7] = __uint_as_float(w.w & 0xffff0000u);
}
__device__ __forceinline__ u32x4 pack8(const float (&f)[8]) { u32x4 w; w.x = cvt_pk_bf16(f[0], f[1]); w.y = cvt_pk_bf16(f[2], f[3]); w.z = cvt_pk_bf16(f[4], f[5]); w.w = cvt_pk_bf16(f[6], f[7]); return w; }
__device__ __forceinline__ float row_rstd(const float* rss, int row) {
    const f32x4* p = (const f32x4*)(rss + (size_t)row * 16); const f32x4 a = p[0], b = p[1], c = p[2], d = p[3];
    const float s = ((a[0] + a[1]) + (a[2] + a[3])) + ((b[0] + b[1]) + (b[2] + b[3])) + ((c[0] + c[1]) + (c[2] + c[3])) + ((d[0] + d[1]) + (d[2] + d[3]));
    return rsqrtf(s * (1.0f / 1024.0f) + 1e-6f);
}

struct EpiG1a {
    static constexpr bool PERM = true, AFTER_DRAIN = false;
    const float* rss; bf16_t* aqk; bf16_t* bqk; bf16_t* y0; bf16_t* y1; bf16_t* cu; bf16_t* scz; float* small;
    __device__ __forceinline__ void operator()(const f32x4 (&acc)[2][2][4][2], const Unit& u, int wr, int wc, int fr, int fq) const {
        const int pn = u.pn; const int row0 = u.pm * 256 + wr * 64 + fr;
        if (pn == 19) {
            if (wc == 0) {
#pragma unroll
                for (int ai = 0; ai < 2; ++ai)
#pragma unroll
                    for (int m = 0; m < 4; ++m) { const int row = row0 + ai * 128 + m * 16; const float rs = rss[row]; float* rp = small + (size_t)row * 32 + 8 * fq;
                        *(f32x4*)(rp) = acc[ai][0][m][0] * rs; *(f32x4*)(rp + 4) = acc[ai][0][m][1] * rs; }
            }
            return;
        }
        bf16_t* base; int ldc, colt; bool act = false;
        if (pn < 6) { base = aqk; ldc = 1536; colt = pn * 256; }
        else if (pn < 9) { base = y0; ldc = 768; colt = (pn - 6) * 256; }
        else if (pn < 12) { base = bqk; ldc = 768; colt = (pn - 9) * 256; }
        else if (pn < 15) { base = y1; ldc = 768; colt = (pn - 12) * 256; }
        else if (pn < 17) { base = cu; ldc = 512; colt = (pn - 15) * 256; }
        else { base = scz; ldc = 512; colt = (pn - 17) * 256; act = true; }
        const int col0 = colt + wc * 32 + 8 * fq;
        float rs8[2][4];
#pragma unroll
        for (int ai = 0; ai < 2; ++ai)
#pragma unroll
            for (int m = 0; m < 4; ++m) rs8[ai][m] = rss[row0 + ai * 128 + m * 16];
        asm volatile("s_waitcnt vmcnt(0)" ::: "memory");
#pragma unroll
        for (int ai = 0; ai < 2; ++ai)
#pragma unroll
            for (int m = 0; m < 4; ++m) { const int row = row0 + ai * 128 + m * 16; const float rs = rs8[ai][m]; bf16_t* rowp = base + (size_t)row * ldc + col0;
#pragma unroll
                for (int bj = 0; bj < 2; ++bj) { f32x4 v0 = acc[ai][bj][m][0] * rs, v1 = acc[ai][bj][m][1] * rs;
                    if (act) {
#pragma unroll
                        for (int j = 0; j < 4; ++j) { v0[j] = siluf_(v0[j]); v1[j] = siluf_(v1[j]); } }
                    u32x4 w; w.x = cvt_pk_bf16(v0[0], v0[1]); w.y = cvt_pk_bf16(v0[2], v0[3]); w.z = cvt_pk_bf16(v1[0], v1[1]); w.w = cvt_pk_bf16(v1[2], v1[3]);
                    *(u32x4*)(rowp + bj * 128) = w; } }
    }
};
struct EpiG1b {
    static constexpr bool PERM = true, AFTER_DRAIN = false;
    const float* rss; bf16_t* y0; bf16_t* y1; bf16_t* sg; const float* sta; const float* stb; const float* anorm; const float* bnorm;
    __device__ __forceinline__ void operator()(const f32x4 (&acc)[2][2][4][2], const Unit& u, int wr, int wc, int fr, int fq) const {
        const int pn = u.pn; const int row0 = u.pm * 256 + wr * 64 + fr;
        if (pn < 6) {
            const int ch = pn * 128 + wc * 32 + 8 * fq, hd = ch / 192;
            float rs8[2][4];
#pragma unroll
            for (int ai = 0; ai < 2; ++ai)
#pragma unroll
                for (int m = 0; m < 4; ++m) rs8[ai][m] = rss[row0 + ai * 128 + m * 16];
            asm volatile("s_waitcnt vmcnt(0)" ::: "memory");
            u32x4 tk[2][4];
#pragma unroll
            for (int ai = 0; ai < 2; ++ai)
#pragma unroll
                for (int m = 0; m < 4; ++m) { const float rs = rs8[ai][m]; const f32x4 o0 = acc[ai][0][m][0] * rs, o1 = acc[ai][0][m][1] * rs, z0 = acc[ai][1][m][0] * rs, z1 = acc[ai][1][m][1] * rs; float t[8];
#pragma unroll
                    for (int j = 0; j < 4; ++j) { t[j] = sigmoidf_(o0[j]) * siluf_(z0[j]); t[4 + j] = sigmoidf_(o1[j]) * siluf_(z1[j]); }
                    tk[ai][m] = pack8(t); }
            asm volatile("" ::: "memory");
            float nw[8];
            { const f32x4 a = *(const f32x4*)(anorm + ch), b = *(const f32x4*)(anorm + ch + 4); nw[0] = a[0]; nw[1] = a[1]; nw[2] = a[2]; nw[3] = a[3]; nw[4] = b[0]; nw[5] = b[1]; nw[6] = b[2]; nw[7] = b[3]; }
#pragma unroll
            for (int ai = 0; ai < 2; ++ai) { f32x4 st4[4]; u32x4 hv4[4];
#pragma unroll
                for (int m = 0; m < 4; ++m) { const int row = row0 + ai * 128 + m * 16; st4[m] = *(const f32x4*)(sta + ((size_t)row * 4 + hd) * (NSTA * 2)); hv4[m] = *(const u32x4*)(y0 + (size_t)row * 768 + ch); }
                asm volatile("s_waitcnt vmcnt(0)" ::: "memory");
#pragma unroll
                for (int m = 0; m < 4; ++m) { const int row = row0 + ai * 128 + m * 16; const float s1 = st4[m][0] + st4[m][2], s2 = st4[m][1] + st4[m][3];
                    const float mean = s1 * (1.0f / 192.0f); const float var = fmaxf(s2 * (1.0f / 192.0f) - mean * mean, 0.0f); const float hr = rsqrtf(var + 1e-6f);
                    float hv[8], t[8], r[8]; unpack8(hv4[m], hv); unpack8(tk[ai][m], t);
#pragma unroll
                    for (int j = 0; j < 8; ++j) r[j] = t[j] * ((hv[j] - mean) * hr * nw[j]);
                    *(u32x4*)(y0 + (size_t)row * 768 + ch) = pack8(r); }
                asm volatile("" ::: "memory"); }
        } else if (pn < 9) {
#pragma unroll
            for (int bj = 0; bj < 2; ++bj) { const int ch = (pn - 6) * 256 + bj * 128 + wc * 32 + 8 * fq, hd = ch / 192;
                float nw[8];
                { const f32x4 a = *(const f32x4*)(bnorm + ch), b = *(const f32x4*)(bnorm + ch + 4); nw[0] = a[0]; nw[1] = a[1]; nw[2] = a[2]; nw[3] = a[3]; nw[4] = b[0]; nw[5] = b[1]; nw[6] = b[2]; nw[7] = b[3]; }
#pragma unroll
                for (int ai = 0; ai < 2; ++ai)
#pragma unroll
                    for (int m = 0; m < 4; ++m) { const int row = row0 + ai * 128 + m * 16; const float rs = rss[row];
                        const f32x2v* sp = (const f32x2v*)(stb + ((size_t)row * 4 + hd) * NSTAT); float s2 = 0.f;
#pragma unroll
                        for (int q = 0; q < NSTAT / 2; ++q) { const f32x2v t = sp[q]; s2 += t[0] + t[1]; }
                        const float hr = rsqrtf(s2 * (1.0f / 192.0f) + 1e-6f);
                        bf16_t* yp = y1 + (size_t)row * 768 + ch; float hv[8]; unpack8(*(const u32x4*)yp, hv);
                        const f32x4 z0 = acc[ai][bj][m][0] * rs, z1 = acc[ai][bj][m][1] * rs; float r[8];
#pragma unroll
                        for (int j = 0; j < 4; ++j) { r[j] = siluf_(z0[j]) * (hv[j] * hr * nw[j]); r[4 + j] = siluf_(z1[j]) * (hv[4 + j] * hr * nw[4 + j]); }
                        *(u32x4*)yp = pack8(r); asm volatile("" ::: "memory"); } }
        } else {
            const int col0 = (pn - 9) * 256 + wc * 32 + 8 * fq;
            float rs8[2][4];
#pragma unroll
            for (int ai = 0; ai < 2; ++ai)
#pragma unroll
                for (int m = 0; m < 4; ++m) rs8[ai][m] = rss[row0 + ai * 128 + m * 16];
            asm volatile("s_waitcnt vmcnt(0)" ::: "memory");
#pragma unroll
            for (int ai = 0; ai < 2; ++ai)
#pragma unroll
                for (int m = 0; m < 4; ++m) { const int row = row0 + ai * 128 + m * 16; const float rs = rs8[ai][m]; bf16_t* rowp = sg + (size_t)row * 3072 + col0;
#pragma unroll
                    for (int bj = 0; bj < 2; ++bj) { const f32x4 v0 = acc[ai][bj][m][0] * rs, v1 = acc[ai][bj][m][1] * rs; float r[8];
#pragma unroll
                        for (int j = 0; j < 4; ++j) { r[j] = sigmoidf_(v0[j]); r[4 + j] = sigmoidf_(v1[j]); }
                        *(u32x4*)(rowp + bj * 128) = pack8(r); } }
        }
    }
};
struct EpiG2 {
    static constexpr bool PERM = true, AFTER_DRAIN = false;
    const bf16_t* ycp; const bf16_t* scz; bf16_t* y2;
    __device__ __forceinline__ void operator()(const f32x4 (&acc)[2][2][4][2], const Unit& u, int wr, int wc, int fr, int fq) const {
        const int row0 = u.pm * 256 + wr * 64 + fr, col0 = u.pn * 256 + wc * 32 + 8 * fq;
#pragma unroll
        for (int ai = 0; ai < 2; ++ai)
#pragma unroll
            for (int m = 0; m < 4; ++m) { const int row = row0 + ai * 128 + m * 16;
#pragma unroll
                for (int bj = 0; bj < 2; ++bj) { const int col = col0 + bj * 128; float a[8], z[8], r[8];
                    unpack8(*(const u32x4*)(ycp + (size_t)row * 512 + col), a); unpack8(*(const u32x4*)(scz + (size_t)row * 512 + col), z);
                    const f32x4 v0 = acc[ai][bj][m][0], v1 = acc[ai][bj][m][1];
#pragma unroll
                    for (int j = 0; j < 4; ++j) { r[j] = a[j] * sigmoidf_(v0[j]) * z[j]; r[4 + j] = a[4 + j] * sigmoidf_(v1[j]) * z[4 + j]; }
                    *(u32x4*)(y2 + (size_t)row * 768 + col) = pack8(r); } asm volatile("" ::: "memory"); }
    }
};
struct EpiG3 {
    static constexpr bool PERM = true, AFTER_DRAIN = false;
    const bf16_t* sg; bf16_t* merged;
    __device__ __forceinline__ void operator()(const f32x4 (&acc)[2][2][4][2], const Unit& u, int wr, int wc, int fr, int fq) const {
        const int br = u.pm >> 6, pm = u.pm & 63, pn = u.pn & 3;
        const int row0 = pm * 256 + wr * 64 + fr, col0 = pn * 256 + wc * 32 + 8 * fq;
        u32x4 pk[2][4][2];
#pragma unroll
        for (int ai = 0; ai < 2; ++ai)
#pragma unroll
            for (int m = 0; m < 4; ++m)
#pragma unroll
                for (int bj = 0; bj < 2; ++bj) { const f32x4 v0 = acc[ai][bj][m][0], v1 = acc[ai][bj][m][1]; u32x4 w; w.x = cvt_pk_bf16(v0[0], v0[1]); w.y = cvt_pk_bf16(v0[2], v0[3]); w.z = cvt_pk_bf16(v1[0], v1[1]); w.w = cvt_pk_bf16(v1[2], v1[3]); pk[ai][m][bj] = w; }
#pragma unroll
        for (int ai = 0; ai < 2; ++ai) {
            u32x4 gq[4][2], pq[4][2];
#pragma unroll
            for (int m = 0; m < 4; ++m) { const int row = row0 + ai * 128 + m * 16;
#pragma unroll
                for (int bj = 0; bj < 2; ++bj) { gq[m][bj] = *(const u32x4*)(sg + (size_t)row * 3072 + br * 1024 + col0 + bj * 128); if (br != 0) pq[m][bj] = *(const u32x4*)(merged + (size_t)row * 1024 + col0 + bj * 128); } }
            asm volatile("s_waitcnt vmcnt(0)" ::: "memory");
#pragma unroll
            for (int m = 0; m < 4; ++m) { const int row = row0 + ai * 128 + m * 16;
#pragma unroll
                for (int bj = 0; bj < 2; ++bj) { u32x4 w; const u32x4 gv = gq[m][bj], av = pk[ai][m][bj], pvv = pq[m][bj];
#pragma unroll
                    for (int hq = 0; hq < 4; ++hq) { const unsigned gw = hq == 0 ? gv.x : hq == 1 ? gv.y : hq == 2 ? gv.z : gv.w, aw = hq == 0 ? av.x : hq == 1 ? av.y : hq == 2 ? av.z : av.w;
                        float r0 = __uint_as_float(gw << 16) * __uint_as_float(aw << 16), r1 = __uint_as_float(gw & 0xffff0000u) * __uint_as_float(aw & 0xffff0000u);
                        if (br != 0) { const unsigned pw = hq == 0 ? pvv.x : hq == 1 ? pvv.y : hq == 2 ? pvv.z : pvv.w; r0 += __uint_as_float(pw << 16); r1 += __uint_as_float(pw & 0xffff0000u); }
                        const unsigned o = cvt_pk_bf16(r0, r1); if (hq == 0) w.x = o; else if (hq == 1) w.y = o; else if (hq == 2) w.z = o; else w.w = o; }
                    *(u32x4*)(merged + (size_t)row * 1024 + col0 + bj * 128) = w; } }
            asm volatile("" ::: "memory"); }
    }
};
struct EpiG4 {
    static constexpr bool PERM = false, AFTER_DRAIN = false;
    const float* xprev; float* xnew; bf16_t* xw; const float* nwn; float* rss; int write_xw;
    __device__ __forceinline__ void operator()(const f32x4 (&acc)[2][2][4][2], const Unit& u, int wr, int wc, int fr, int fq) const {
        const int row0 = u.pm * 256 + wr * 64 + fr, col0 = u.pn * 256 + wc * 32 + 4 * fq;
        f32x4 nv[2][2];
#pragma unroll
        for (int bj = 0; bj < 2; ++bj)
#pragma unroll
            for (int n = 0; n < 2; ++n) nv[bj][n] = *(const f32x4*)(nwn + col0 + bj * 128 + n * 16);
#pragma unroll
        for (int ai = 0; ai < 2; ++ai)
#pragma unroll
            for (int mp = 0; mp < 2; ++mp) {
                f32x4 xr[2][2][2];
#pragma unroll
                for (int q = 0; q < 2; ++q) { const size_t off = (size_t)(row0 + ai * 128 + (2 * mp + q) * 16) * 1024 + col0;
#pragma unroll
                    for (int bj = 0; bj < 2; ++bj)
#pragma unroll
                        for (int n = 0; n < 2; ++n) xr[q][bj][n] = *(const f32x4*)(xprev + off + bj * 128 + n * 16); }
                asm volatile("s_waitcnt vmcnt(0)" ::: "memory");
#pragma unroll
                for (int q = 0; q < 2; ++q) { const int m = 2 * mp + q; const int row = row0 + ai * 128 + m * 16; const size_t off = (size_t)row * 1024 + col0; float ss = 0.f;
#pragma unroll
                    for (int bj = 0; bj < 2; ++bj)
#pragma unroll
                        for (int n = 0; n < 2; ++n) { const f32x4 xv = xr[q][bj][n] + acc[ai][bj][m][n];
                            *(f32x4*)(xnew + off + bj * 128 + n * 16) = xv; ss += (xv[0] * xv[0] + xv[1] * xv[1]) + (xv[2] * xv[2] + xv[3] * xv[3]);
                            if (write_xw) { const f32x4 t = xv * nv[bj][n]; u32x2 w; w.x = cvt_pk_bf16(t[0], t[1]); w.y = cvt_pk_bf16(t[2], t[3]); *(u32x2*)(xw + off + bj * 128 + n * 16) = w; } }
                    ss += __shfl_xor(ss, 16); ss += __shfl_xor(ss, 32);
                    if (fq == 0) rss[(size_t)row * 16 + u.pn * 4 + wc] = ss; }
                asm volatile("" ::: "memory"); }
    }
};
struct BranchOrder {
    int G, c;
    __device__ bool next(int i, Unit& u) const {
        const int j = i / 3, br = i - 3 * j; const long L = (long)j * G + c; if (L >= 256) return false;
        int wgid = (int)L; { const int q = 256 / 8, xcd = wgid % 8, off = wgid / 8; wgid = xcd * q + off; }
        const int nig = 8 * 4, gid = wgid / nig, fm = gid * 8; const int pm = fm + ((wgid % nig) % 8), pn = (wgid % nig) / 8;
        u.pm = br * 64 + pm; u.pn = br * 4 + pn; return true;
    }
    __device__ __forceinline__ void a_ready(const Unit&) const {}
    __device__ __forceinline__ void done(const Unit&) const {}
};

template <int KK> __device__ __forceinline__ f32x4 mma_tile(const LAS bf16_t* A, int lda, int r0, const LAS bf16_t* Bt, int ldb, int c0, f32x4 acc, int lane) {
    const int fr = lane & 15, fq = lane >> 4;
    const LAS bf16_t* ap = A + (r0 + fr) * lda + fq * 8; const LAS bf16_t* bp = Bt + (c0 + fr) * ldb + fq * 8;
#pragma unroll
    for (int k = 0; k < KK; k += 32) { const bf16x8 a = *(const LAS bf16x8*)(ap + k); const bf16x8 b = *(const LAS bf16x8*)(bp + k); acc = __builtin_amdgcn_mfma_f32_16x16x32_bf16(a, b, acc, 0, 0, 0); }
    return acc;
}
template <int CTRL, int RM> __device__ __forceinline__ float dpp_or(float oldv, float v) { return __int_as_float(__builtin_amdgcn_update_dpp(__float_as_int(oldv), __float_as_int(v), CTRL, RM, 0xF, false)); }
__device__ __forceinline__ float wave_scan_add(float v, int) {
    v += dpp_or<0x111, 0xF>(0.f, v); v += dpp_or<0x112, 0xF>(0.f, v); v += dpp_or<0x114, 0xF>(0.f, v); v += dpp_or<0x118, 0xF>(0.f, v);
    v += dpp_or<0x142, 0xA>(0.f, v); v += dpp_or<0x143, 0xC>(0.f, v); return v;
}
__device__ __forceinline__ float wave_scan_max(float v, int) {
    v = fmaxf(v, dpp_or<0x111, 0xF>(v, v)); v = fmaxf(v, dpp_or<0x112, 0xF>(v, v)); v = fmaxf(v, dpp_or<0x114, 0xF>(v, v)); v = fmaxf(v, dpp_or<0x118, 0xF>(v, v));
    v = fmaxf(v, dpp_or<0x142, 0xA>(v, v)); v = fmaxf(v, dpp_or<0x143, 0xC>(v, v)); return v;
}

template <int CTRL> __device__ __forceinline__ float dppf(float v) { return __int_as_float(__builtin_amdgcn_update_dpp(0, __float_as_int(v), CTRL, 0xF, 0xF, true)); }
__device__ __forceinline__ float rflf(float v) { return __int_as_float(__builtin_amdgcn_readfirstlane(__float_as_int(v))); }
__device__ __forceinline__ float quadsum(float v) { v += dppf<0xB1>(v); v += dppf<0x4E>(v); return v; }
__device__ __forceinline__ float rowsum16(float v) { v += dppf<0xB1>(v); v += dppf<0x4E>(v); v += dppf<0x141>(v); v += dppf<0x140>(v); return v; }
__device__ __forceinline__ float rowbcast4(float v, int r) { switch (r) { case 0: return dppf<0x150>(v); case 1: return dppf<0x154>(v); case 2: return dppf<0x158>(v); default: return dppf<0x15C>(v); } }
__device__ __forceinline__ int colmap(int type, int n) {
    if (type == 1) {
        if (n < 2304) return n;
        if (n < 3072) return 3848 + (n - 2304);
        if (n < 3840) return 4616 + (n - 3072);
        if (n < 4352) return 6168 + (n - 3840);
        if (n < 4864) return 6680 + (n - 4352);
        const int j = n - 4864; if (j < 4) return 3072 + j; if (j < 8) return 3076 + (j - 4); if (j < 24) return 5384 + (j - 8); return -1;
    }
    if (type == 2) {
        if (n < 1536) { const int t = n >> 8, hf = (n >> 7) & 1, x = n & 127; return (hf ? 3080 : 2304) + 128 * t + x; }
        if (n < 2304) return 5400 + (n - 1536);
        return 7192 + (n - 2304);
    }
    return n;
}
__device__ __forceinline__ void convert_job(LAS float* tl, const float* src, int lds_, int ks, bf16_t* dst, int kd, int nrows, int type, int G, int c) {
    int tid_l = threadIdx.x; asm volatile("" : "+v"(tid_l)); const int tid = tid_l; const int nkt = kd / 64, nnt = nrows / 64, ntiles = nkt * nnt;
    float pf[8];
#define CONV_LOAD(tt) do { const int kt_ = (tt) % nkt, nt_ = (tt) / nkt; const int k0_ = kt_ * 64, n0_ = nt_ * 64; const int sc_ = colmap(type, n0_ + (tid & 63)); \
        _Pragma("unroll") for (int i_ = 0; i_ < 8; ++i_) { const int kk_ = (tid >> 6) + 8 * i_; float v_ = 0.f; if (sc_ >= 0 && (k0_ + kk_) < ks) v_ = src[(size_t)(k0_ + kk_) * lds_ + sc_]; pf[i_] = v_; } } while (0)
    if (c < ntiles) CONV_LOAD(c);
    for (int t = c; t < ntiles; t += G) {
        const int kt = t % nkt, nt = t / nkt; const int k0 = kt * 64, n0 = nt * 64;
        asm volatile("s_waitcnt vmcnt(0)" ::: "memory");
        { const int nn = tid & 63;
#pragma unroll
          for (int i = 0; i < 8; ++i) { const int kk = (tid >> 6) + 8 * i; tl[nn * 65 + kk] = pf[i]; } }
        if (t + G < ntiles) CONV_LOAD(t + G);
        __syncthreads();
        { const int nn = tid >> 3, kseg = tid & 7; float f[8];
#pragma unroll
          for (int j = 0; j < 8; ++j) f[j] = tl[nn * 65 + kseg * 8 + j];
          *(u32x4*)(dst + (size_t)(n0 + nn) * kd + k0 + kseg * 8) = pack8(f); }
        __syncthreads();
    }
#undef CONV_LOAD
}
__device__ __forceinline__ void phase_convert(LAS unsigned char* lds, const Params p, int layer) {
    LAS float* tl = (LAS float*)lds; const int G = gridDim.x, c = blockIdx.x; unsigned char* ws = p.ws;
    const float* w_in = p.in[2] + (size_t)layer * 1024 * 10264;
    convert_job(tl, w_in, 10264, 1024, (bf16_t*)(ws + OFF_W1A), 1024, N1A, 1, G, c);
    convert_job(tl, w_in, 10264, 1024, (bf16_t*)(ws + OFF_W1B), 1024, N1B, 2, G, c);
    convert_job(tl, p.in[17] + (size_t)layer * 512 * 512, 512, 512, (bf16_t*)(ws + OFF_WGLU), 512, 512, 0, G, c);
    convert_job(tl, p.in[18] + (size_t)layer * 768 * 1024, 1024, 768, (bf16_t*)(ws + OFF_WBR), 768, 1024, 0, G, c);
    convert_job(tl, p.in[19] + (size_t)layer * 768 * 1024, 1024, 768, (bf16_t*)(ws + OFF_WBR) + (size_t)1024 * 768, 768, 1024, 0, G, c);
    convert_job(tl, p.in[20] + (size_t)layer * 512 * 1024, 1024, 512, (bf16_t*)(ws + OFF_WBR) + (size_t)2 * 1024 * 768, 768, 1024, 0, G, c);
    convert_job(tl, p.in[21] + (size_t)layer * 1024 * 1024, 1024, 1024, (bf16_t*)(ws + OFF_WOUT), 1024, 1024, 0, G, c);
    if (layer > 0) { const float* rss = (const float*)(ws + OFF_RSS); float* rstd = (float*)(ws + OFF_RSTD); int t2 = threadIdx.x; asm volatile("" : "+v"(t2)); for (int row = c * NTHR + t2; row < MTOK; row += G * NTHR) rstd[row] = row_rstd(rss, row); }
}
__device__ __forceinline__ void phase_prologue_x(const Params p) {
    int tid_l = threadIdx.x; asm volatile("" : "+v"(tid_l)); const int tid = tid_l, lane = tid & 63, wid = tid >> 6; const int G = gridDim.x; unsigned char* ws = p.ws;
    const float* x = p.in[0]; const float* nw = p.in[1]; bf16_t* xw = (bf16_t*)(ws + OFF_XW); float* rstd = (float*)(ws + OFF_RSTD);
    f32x4 nv[4];
#pragma unroll
    for (int i = 0; i < 4; ++i) nv[i] = *(const f32x4*)(nw + i * 256 + lane * 4);
    for (int row = blockIdx.x * 8 + wid; row < MTOK; row += G * 8) {
        float ss = 0.f;
#pragma unroll
        for (int i = 0; i < 4; ++i) { const f32x4 v = *(const f32x4*)(x + (size_t)row * 1024 + i * 256 + lane * 4); ss += (v[0] * v[0] + v[1] * v[1]) + (v[2] * v[2] + v[3] * v[3]);
            const f32x4 t = v * nv[i]; u32x2 w; w.x = cvt_pk_bf16(t[0], t[1]); w.y = cvt_pk_bf16(t[2], t[3]); *(u32x2*)(xw + (size_t)row * 1024 + i * 256 + lane * 4) = w; }
#pragma unroll
        for (int o = 32; o >= 1; o >>= 1) ss += __shfl_xor(ss, o);
        if (lane == 0) rstd[row] = rsqrtf(ss * (1.0f / 1024.0f) + 1e-6f);
    }
}

constexpr size_t OFF_QG = OFF_MERGED;
constexpr size_t OFF_SCO = OFF_MERGED + (size_t)MTOK * 768 * 2;
constexpr size_t OFF_KTG = OFF_SG + (size_t)MTOK * 2304 * 2;
constexpr size_t OFF_Y2 = OFF_Y + (size_t)2 * MTOK * 768 * 2;
constexpr size_t OFF_KTB = OFF_Y2;
constexpr size_t OFF_PGB = OFF_KTB + (size_t)1024 * 96 * 64 * 2;
constexpr size_t OFF_ELAST = OFF_PGB + (size_t)1024 * 64 * 64 * 2;
constexpr size_t OFF_GT = OFF_ELAST + (size_t)1024 * 96 * 4;
constexpr size_t OFF_CHS = OFF_GT + (size_t)1024 * 3 * 64 * 4;
static_assert(OFF_CHS + 1024 * 2 * 4 <= OFF_Y2 + (size_t)MTOK * 768 * 2, "Y[2] scratch overflow");

__device__ __forceinline__ void mlstm_pre(LAS unsigned char* lds, const Params p, int layer, int item) {
    int tid_l = threadIdx.x; asm volatile("" : "+v"(tid_l)); const int tid = tid_l, lane = tid & 63, wid = __builtin_amdgcn_readfirstlane(tid >> 6), fr = lane & 15, fq = lane >> 4;
    const int h = item & 3, ci = item >> 2, c = ci & 63, b = ci >> 6, row0 = ci * 64;
    unsigned char* ws = p.ws;
    const bf16_t* aqk = (const bf16_t*)(ws + OFF_SG); const float* small = (const float*)(ws + OFF_SMALL);
    bf16_t* qg = (bf16_t*)(ws + OFF_QG); bf16_t* sco = (bf16_t*)(ws + OFF_SCO) + (size_t)item * 4096; bf16_t* ktg = (bf16_t*)(ws + OFF_KTG) + (size_t)item * 192 * 64;
    float* gt = (float*)(ws + OFF_GT) + (size_t)item * 192; float* chs = (float*)(ws + OFF_CHS) + item * 2;
    const float* convw = p.in[3] + (size_t)layer * 4 * 1536; const float bi = p.in[4][layer * 8 + h], bfg = p.in[4][layer * 8 + 4 + h];
    LAS bf16_t* Qs = (LAS bf16_t*)lds; LAS bf16_t* Ks = Qs + 64 * 200;
    const float kscale = 0.07216878364870322f;
    if (wid == 0) {
        const float ip = small[(size_t)(row0 + lane) * 32 + h] + bi; const float fp = small[(size_t)(row0 + lane) * 32 + 4 + h] + bfg;
        const float bc = wave_scan_add(logsigmoidf_(fp), lane); const float g = ip - bc; const float cm = wave_scan_max(g, lane);
        gt[lane] = g; gt[64 + lane] = cm; gt[128 + lane] = bc;
        if (lane == 63) { chs[0] = bc; chs[1] = cm; }
    }
#pragma unroll
    for (int task = tid; task < 64 * 24; task += NTHR) {
        const int t = task / 24, d8 = task - t * 24; const int ch = h * 192 + d8 * 8;
        float aq[8], ak[8];
#pragma unroll
        for (int j = 0; j < 8; ++j) { aq[j] = 0.f; ak[j] = 0.f; }
#pragma unroll
        for (int tap = 0; tap < 4; ++tap) { const int tt = c * 64 + t - 3 + tap;
            if (tt >= 0) { const bf16_t* rp = aqk + (size_t)(b * SEQ + tt) * 1536 + ch; float rq[8], rk[8]; unpack8(*(const u32x4*)rp, rq); unpack8(*(const u32x4*)(rp + 768), rk);
                const float* wq = convw + tap * 1536 + ch; const f32x4 q0 = *(const f32x4*)wq, q1 = *(const f32x4*)(wq + 4), k0 = *(const f32x4*)(wq + 768), k1 = *(const f32x4*)(wq + 772);
#pragma unroll
                for (int j = 0; j < 4; ++j) { aq[j] += q0[j] * rq[j]; aq[4 + j] += q1[j] * rq[4 + j]; ak[j] += k0[j] * rk[j]; ak[4 + j] += k1[j] * rk[4 + j]; } } }
#pragma unroll
        for (int j = 0; j < 8; ++j) { aq[j] = siluf_(aq[j]); ak[j] = siluf_(ak[j]) * kscale; }
        const u32x4 qw = pack8(aq);
        *(LAS u32x4*)(Qs + t * 200 + d8 * 8) = qw; *(LAS u32x4*)(Ks + t * 200 + d8 * 8) = pack8(ak);
        asm volatile("s_waitcnt vmcnt(0)" ::: "memory");
        *(u32x4*)(qg + (size_t)(row0 + t) * 768 + ch) = qw;
    }
    if (c < VGC) { const bf16_t* y0 = (const bf16_t*)(ws + OFF_Y); bf16_t* vg = (bf16_t*)(ws + OFF_VG) + (size_t)((b * VGC + c) * 4 + h) * 12288;
#pragma unroll
        for (int k = 0; k < 3; ++k) { const int i = tid + NTHR * k; const int t = i / 24, d8 = i - t * 24; *(u32x4*)(vg + t * 192 + d8 * 8) = *(const u32x4*)(y0 + (size_t)(row0 + t) * 768 + h * 192 + d8 * 8); } }
    __syncthreads();
    { const int tr = wid >> 1;
#pragma unroll
      for (int q = 0; q < 2; ++q) { const int tc = (wid & 1) * 2 + q; f32x4 a = (f32x4){0.f, 0.f, 0.f, 0.f};
          if (tc <= tr) a = mma_tile<192>(Qs, 200, 16 * tr, Ks, 200, 16 * tc, a, lane);
          const int s = 16 * tc + fr;
#pragma unroll
          for (int r = 0; r < 4; ++r) { const int t = 16 * tr + 4 * fq + r; sco[t * 64 + s] = f2bf((s <= t) ? a[r] : 0.f); } } }
    for (int task = tid; task < 192 * 8; task += NTHR) { const int s8 = task / 192, d = task - s8 * 192; float f[8];
#pragma unroll
        for (int j = 0; j < 8; ++j) f[j] = bf2f(Ks[(s8 * 8 + j) * 200 + d]);
        *(u32x4*)(ktg + d * 64 + s8 * 8) = pack8(f); }
    __syncthreads();
}

__device__ __forceinline__ void gla_pre(LAS unsigned char* lds, const Params p, int layer, int item) {
    int tid_l = threadIdx.x; asm volatile("" : "+v"(tid_l)); const int tid = tid_l, lane = tid & 63, wid = __builtin_amdgcn_readfirstlane(tid >> 6), fr = lane & 15, fq = lane >> 4;
    const int h = item & 3, ci = item >> 2, row0 = ci * 64;
    unsigned char* ws = p.ws;
    bf16_t* bqk = (bf16_t*)(ws + OFF_SG) + (size_t)MTOK * 1536; const float* small = (const float*)(ws + OFF_SMALL);
    bf16_t* ktb = (bf16_t*)(ws + OFF_KTB) + (size_t)item * 96 * 64; bf16_t* pgb = (bf16_t*)(ws + OFF_PGB) + (size_t)item * 4096; float* elast = (float*)(ws + OFF_ELAST) + item * 96;
    const float* walpha = p.in[6] + (size_t)layer * 16 * 384; const float* balpha = p.in[7] + (size_t)layer * 384;
    LAS bf16_t* Qs = (LAS bf16_t*)lds; LAS bf16_t* Ks = Qs + 64 * 104; LAS float* Bc = (LAS float*)(Ks + 64 * 104); LAS float* BAs = Bc + 64 * 97;
    const int gd = tid % 96, gtq = tid / 96; float wal[16]; float bal = 0.f;
    if (tid < 384) {
#pragma unroll
        for (int r = 0; r < 16; ++r) wal[r] = walpha[r * 384 + h * 96 + gd];
        bal = balpha[h * 96 + gd]; }
    const float qscale = 0.10206207261596575f;
    u32x4 rq[2], rk[2];
#pragma unroll
    for (int k = 0; k < 2; ++k) { const int task = tid + NTHR * k; if (task < 768) { const int t = task / 12, d8 = task - t * 12; const bf16_t* rp = bqk + (size_t)(row0 + t) * 768 + h * 96 + d8 * 8; rq[k] = *(const u32x4*)rp; rk[k] = *(const u32x4*)(rp + 384); } }
    for (int i = tid; i < 64 * 4; i += NTHR) { const int t = i >> 2, q = i & 3; *(LAS f32x4*)(BAs + t * 16 + q * 4) = *(const f32x4*)(small + (size_t)(row0 + t) * 32 + 8 + q * 4); }
    __syncthreads();
    if (tid < 384) {
#pragma unroll 4
        for (int i = 0; i < 16; ++i) { const int t = gtq * 16 + i; float z = bal;
#pragma unroll
            for (int r = 0; r < 16; ++r) z += BAs[t * 16 + r] * wal[r];
            Bc[t * 97 + gd] = logsigmoidf_(z) * (1.0f / 16.0f); } }
    __syncthreads();
    for (int i = 0; i < 12; ++i) { const int d = wid * 12 + i; const float v = wave_scan_add(Bc[lane * 97 + d], lane); Bc[lane * 97 + d] = v; }
    __syncthreads();
    asm volatile("s_waitcnt vmcnt(0)" ::: "memory");
#pragma unroll
    for (int kk = 0; kk < 2; ++kk) { const int task = tid + NTHR * kk; if (task >= 768) continue;
        const int t = task / 12, d8 = task - t * 12; bf16_t* rp = bqk + (size_t)(row0 + t) * 768 + h * 96 + d8 * 8; float q[8], k[8];
        unpack8(rq[kk], q); unpack8(rk[kk], k);
#pragma unroll
        for (int j = 0; j < 8; ++j) { const float bc = Bc[t * 97 + d8 * 8 + j]; q[j] = q[j] * qscale * __expf(bc); k[j] = k[j] * __expf(-bc); }
        const u32x4 qw = pack8(q);
        *(LAS u32x4*)(Qs + t * 104 + d8 * 8) = qw; *(LAS u32x4*)(Ks + t * 104 + d8 * 8) = pack8(k);
        *(u32x4*)rp = qw;
    }
    if (tid < 96) elast[tid] = __expf(Bc[63 * 97 + tid]);
    __syncthreads();
    { const int tr = wid >> 1;
#pragma unroll
      for (int q = 0; q < 2; ++q) { const int tc = (wid & 1) * 2 + q; f32x4 a = (f32x4){0.f, 0.f, 0.f, 0.f};
          if (tc <= tr) a = mma_tile<96>(Qs, 104, 16 * tr, Ks, 104, 16 * tc, a, lane);
          const int s = 16 * tc + fr;
#pragma unroll
          for (int r = 0; r < 4; ++r) { const int t = 16 * tr + 4 * fq + r; pgb[t * 64 + s] = f2bf((s <= t) ? a[r] : 0.f); } } }
    for (int task = tid; task < 96 * 8; task += NTHR) { const int s8 = task / 96, d = task - s8 * 96; float f[8];
#pragma unroll
        for (int j = 0; j < 8; ++j) f[j] = bf2f(Ks[(s8 * 8 + j) * 104 + d]);
        *(u32x4*)(ktb + d * 64 + s8 * 8) = pack8(f); }
    __syncthreads();
}

__device__ __forceinline__ void mlstm_item(LAS unsigned char* lds, const Params p, int layer, int item) {
    int tid_l = threadIdx.x; asm volatile("" : "+v"(tid_l)); const int tid = tid_l, lane = tid & 63, wid = __builtin_amdgcn_readfirstlane(tid >> 6), fr = lane & 15, fq = lane >> 4;
    const int seqhalf = item % 3, half = (item / 3) & 1, bh = item / 6, h = bh & 3, b = bh >> 2, e_base = half * 96;
    const int cout0 = seqhalf == 0 ? 0 : (seqhalf == 1 ? 21 : 42), cend = seqhalf == 0 ? 21 : (seqhalf == 1 ? 42 : 64);
    unsigned char* ws = p.ws;
    bf16_t* y0 = (bf16_t*)(ws + OFF_Y); float* sta = (float*)(ws + OFF_STA);
    const bf16_t* qg = (const bf16_t*)(ws + OFF_QG); const bf16_t* sco = (const bf16_t*)(ws + OFF_SCO); const bf16_t* ktg = (const bf16_t*)(ws + OFF_KTG);
    const float* gt = (const float*)(ws + OFF_GT); const float* chs = (const float*)(ws + OFF_CHS); const bf16_t* vg = (const bf16_t*)(ws + OFF_VG);
    LAS bf16_t* Qs = (LAS bf16_t*)lds; LAS bf16_t* KTw = Qs + 64 * 200; LAS bf16_t* VTs = KTw + 192 * 72; LAS bf16_t* Ss = VTs + 96 * 72; LAS bf16_t* CTs = Ss + 64 * 72;
    LAS float* fv = (LAS float*)(CTs + 96 * 200);
    LAS float* cmS = fv; LAS float* bcS = fv + 64; LAS float* dinvS = fv + 128; LAS float* wintS = fv + 192; LAS float* nv0 = fv + 256; LAS float* nv1 = nv0 + 192; LAS float* stS = nv1 + 192;
    for (int i = tid; i < 384; i += NTHR) nv0[i] = 0.f;
    f32x4 cacc[12];
#pragma unroll
    for (int i = 0; i < 12; ++i) cacc[i] = (f32x4){0.f, 0.f, 0.f, 0.f};
    float mstate = 0.f;
    u32x4 pq[3], pk[3], ps; u32x2 pv[3]; float pg8v[8], pcm, pcm2 = 0.f, pbc2 = 0.f; float pbend, pgmax;
    const int st_t = tid >> 3, st_s8 = tid & 7;
#define MLSTM_PREFETCH(cc) do { const int ch_ = ((b * 64 + (cc)) * 4 + h); const int r0_ = b * SEQ + (cc) * 64; \
        const bool vc_ = (cc) < cout0; const bf16_t* vb_ = vc_ ? vg + (size_t)((b * VGC + (cc)) * 4 + h) * 12288 + e_base : y0 + (size_t)r0_ * 768 + h * 192 + e_base; const int vp_ = vc_ ? 192 : 768; \
        _Pragma("unroll") for (int k_ = 0; k_ < 3; ++k_) { const int i_ = tid + NTHR * k_; const int t_ = i_ / 24, d8_ = i_ - t_ * 24; if ((cc) >= cout0) pq[k_] = *(const u32x4*)(qg + (size_t)(r0_ + t_) * 768 + h * 192 + d8_ * 8); \
            pk[k_] = *(const u32x4*)(ktg + (size_t)ch_ * 12288 + (size_t)i_ * 8); \
            pv[k_] = *(const u32x2*)(vb_ + (size_t)t_ * vp_ + d8_ * 4); } \
        if ((cc) >= cout0) ps = *(const u32x4*)(sco + (size_t)ch_ * 4096 + st_t * 64 + st_s8 * 8); \
        { const f32x4 ga_ = *(const f32x4*)(gt + (size_t)ch_ * 192 + st_s8 * 8), gb_ = *(const f32x4*)(gt + (size_t)ch_ * 192 + st_s8 * 8 + 4); \
          pg8v[0] = ga_[0]; pg8v[1] = ga_[1]; pg8v[2] = ga_[2]; pg8v[3] = ga_[3]; pg8v[4] = gb_[0]; pg8v[5] = gb_[1]; pg8v[6] = gb_[2]; pg8v[7] = gb_[3]; } \
        pcm = gt[(size_t)ch_ * 192 + 64 + st_t]; \
        if (tid < 64) { pcm2 = gt[(size_t)ch_ * 192 + 64 + tid]; pbc2 = gt[(size_t)ch_ * 192 + 128 + tid]; } \
        pbend = chs[ch_ * 2]; pgmax = chs[ch_ * 2 + 1]; } while (0)
    MLSTM_PREFETCH(0);
    __syncthreads();
    for (int c = 0; c < cend; ++c) {
        const int row0 = b * SEQ + c * 64; const bool do_out = (c >= cout0);
        LAS float* ncur = (c & 1) ? nv1 : nv0; LAS float* nnext = (c & 1) ? nv0 : nv1;
        asm volatile("s_waitcnt vmcnt(0)" ::: "memory");
        const float mx = rflf(fmaxf(mstate, pgmax)); const float mnew = rflf(pbend + mx); const float wprev = rflf(__expf(mstate - mx)); const float mcur = mstate;
        { float wk8[8];
#pragma unroll
          for (int j = 0; j < 8; ++j) wk8[j] = __expf(pg8v[j] - mx);
#pragma unroll
          for (int k = 0; k < 3; ++k) { const int i = tid + NTHR * k; const int t = i / 24, d8 = i - t * 24; if (do_out) *(LAS u32x4*)(Qs + t * 200 + d8 * 8) = pq[k];
              const int d = i >> 3; float f[8]; unpack8(pk[k], f);
#pragma unroll
              for (int j = 0; j < 8; ++j) f[j] *= wk8[j];
              *(LAS u32x4*)(KTw + d * 72 + st_s8 * 8) = pack8(f);
              const int ve = d8 * 4; VTs[(ve + 0) * 72 + t] = (bf16_t)(pv[k].x & 0xffffu); VTs[(ve + 1) * 72 + t] = (bf16_t)(pv[k].x >> 16); VTs[(ve + 2) * 72 + t] = (bf16_t)(pv[k].y & 0xffffu); VTs[(ve + 3) * 72 + t] = (bf16_t)(pv[k].y >> 16); }
          if (do_out) { float f[8]; unpack8(ps, f); const float mm = fmaxf(mcur, pcm);
#pragma unroll
            for (int j = 0; j < 8; ++j) f[j] = (st_s8 * 8 + j <= st_t) ? f[j] * __expf(pg8v[j] - mm) : 0.f;
            *(LAS u32x4*)(Ss + st_t * 72 + st_s8 * 8) = pack8(f); } }
        if (tid < 64) { cmS[tid] = pcm2; bcS[tid] = pbc2; }
        if (wid < 6 && do_out) {
#pragma unroll
            for (int dc = 0; dc < 12; ++dc) { u32x2 w; w.x = cvt_pk_bf16(cacc[dc][0], cacc[dc][1]); w.y = cvt_pk_bf16(cacc[dc][2], cacc[dc][3]); *(LAS u32x2*)(CTs + (16 * wid + fr) * 200 + 16 * dc + 4 * fq) = w; } }
        if (c + 1 < cend) MLSTM_PREFETCH(c + 1);
        __syncthreads();
        f32x4 onum[4];
        if (wid < 6) {
            const LAS bf16_t* vtp = VTs + (16 * wid + fr) * 72 + 8 * fq; const bf16x8 vt0 = *(const LAS bf16x8*)vtp, vt1 = *(const LAS bf16x8*)(vtp + 32);
#pragma unroll
            for (int dc = 0; dc < 12; ++dc) { const LAS bf16_t* kp = KTw + (16 * dc + fr) * 72 + 8 * fq; const bf16x8 a0 = *(const LAS bf16x8*)kp, a1 = *(const LAS bf16x8*)(kp + 32);
                cacc[dc] = cacc[dc] * wprev; cacc[dc] = __builtin_amdgcn_mfma_f32_16x16x32_bf16(a0, vt0, cacc[dc], 0, 0, 0); cacc[dc] = __builtin_amdgcn_mfma_f32_16x16x32_bf16(a1, vt1, cacc[dc], 0, 0, 0);
                if ((dc & 3) == 3) asm volatile("" ::: "memory"); }
            const LAS bf16_t* ctp = CTs + (16 * wid + fr) * 200 + 8 * fq;
            if (do_out) {
#pragma unroll
            for (int tr = 0; tr < 4; ++tr) { f32x4 a = (f32x4){0.f, 0.f, 0.f, 0.f}; const LAS bf16_t* qp = Qs + (16 * tr + fr) * 200 + 8 * fq;
#pragma unroll
                for (int k = 0; k < 6; ++k) a = __builtin_amdgcn_mfma_f32_16x16x32_bf16(*(const LAS bf16x8*)(qp + 32 * k), *(const LAS bf16x8*)(ctp + 32 * k), a, 0, 0, 0);
#pragma unroll
                for (int r = 0; r < 4; ++r) { const float cmv = cmS[16 * tr + 4 * fq + r]; a[r] *= __expf(mcur - fmaxf(mcur, cmv)); }
                const LAS bf16_t* sp = Ss + (16 * tr + fr) * 72 + 8 * fq;
                a = __builtin_amdgcn_mfma_f32_16x16x32_bf16(*(const LAS bf16x8*)sp, vt0, a, 0, 0, 0); a = __builtin_amdgcn_mfma_f32_16x16x32_bf16(*(const LAS bf16x8*)(sp + 32), vt1, a, 0, 0, 0);
                onum[tr] = a; asm volatile("" ::: "memory"); } }
        } else {
            const int ht = tid - 384, row = ht >> 1, hf = ht & 1; float rs = 0.f, qn = 0.f;
            if (do_out) {
#pragma unroll
            for (int i = 0; i < 4; ++i) { float f[8]; unpack8(*(const LAS u32x4*)(Ss + row * 72 + hf * 32 + i * 8), f); rs += ((f[0] + f[1]) + (f[2] + f[3])) + ((f[4] + f[5]) + (f[6] + f[7])); }
#pragma unroll
            for (int i = 0; i < 12; ++i) { float f[8]; unpack8(*(const LAS u32x4*)(Qs + row * 200 + hf * 96 + i * 8), f);
#pragma unroll
                for (int j = 0; j < 8; ++j) qn += f[j] * ncur[hf * 96 + i * 8 + j]; }
            rs += dppf<0xB1>(rs); qn += dppf<0xB1>(qn);
            const float mm = fmaxf(mcur, cmS[row]); const float wint = __expf(mcur - mm); const float emt = __expf(-(bcS[row] + mm));
            const float den = rs + wint * qn; const float dinv = 1.0f / fmaxf(fabsf(den), emt);
            if (hf == 0) { dinvS[row] = dinv; wintS[row] = wint; } }
#pragma unroll
            for (int rep = 0; rep < 2; ++rep) { const int d = ht + 128 * rep; if (d < 192) { float s = 0.f;
#pragma unroll
                for (int i = 0; i < 8; ++i) { float f[8]; unpack8(*(const LAS u32x4*)(KTw + d * 72 + i * 8), f); s += ((f[0] + f[1]) + (f[2] + f[3])) + ((f[4] + f[5]) + (f[6] + f[7])); }
                nnext[d] = wprev * ncur[d] + s; } }
            if (c > cout0 && ht < 64) { float s1 = 0.f, s2 = 0.f;
#pragma unroll
                for (int w = 0; w < 6; ++w) { s1 += stS[(w * 64 + ht) * 2]; s2 += stS[(w * 64 + ht) * 2 + 1]; }
                *(f32x2v*)(sta + (((size_t)(row0 - 64 + ht) * 4 + h) * NSTA + half) * 2) = (f32x2v){s1, s2}; }
        }
        mstate = mnew;
        __syncthreads();
        if (wid < 6 && do_out) {
#pragma unroll
            for (int tr = 0; tr < 4; ++tr) { float s1[4], s2[4];
#pragma unroll
                for (int r = 0; r < 4; ++r) { const int t = 16 * tr + 4 * fq + r; const float o = onum[tr][r] * dinvS[t];
                    y0[(size_t)(row0 + t) * 768 + h * 192 + e_base + 16 * wid + fr] = f2bf(o);
                    s1[r] = rowsum16(o); s2[r] = rowsum16(o * o); }
                if (fr == 0) {
#pragma unroll
                    for (int r = 0; r < 4; ++r) { const int t = 16 * tr + 4 * fq + r; *(LAS f32x2v*)(stS + (wid * 64 + t) * 2) = (f32x2v){s1[r], s2[r]}; } }
                asm volatile("" ::: "memory"); }
        }
    }
    __syncthreads();
    if (tid < 64) { const int row0 = b * SEQ + (cend - 1) * 64; float s1 = 0.f, s2 = 0.f;
#pragma unroll
        for (int w = 0; w < 6; ++w) { s1 += stS[(w * 64 + tid) * 2]; s2 += stS[(w * 64 + tid) * 2 + 1]; }
        *(f32x2v*)(sta + (((size_t)(row0 + tid) * 4 + h) * NSTA + half) * 2) = (f32x2v){s1, s2}; }
    __syncthreads();
#undef MLSTM_PREFETCH
}

__device__ __forceinline__ void gla_item(LAS unsigned char* lds, const Params p, int layer, int item) {
    int tid_l = threadIdx.x; asm volatile("" : "+v"(tid_l)); const int tid = tid_l, lane = tid & 63, wid = __builtin_amdgcn_readfirstlane(tid >> 6), fr = lane & 15, fq = lane >> 4;
    const int es = item % 6, bh = item / 6, h = bh & 3, b = bh >> 2, e0 = es * 32;
    unsigned char* ws = p.ws;
    const bf16_t* bqk = (const bf16_t*)(ws + OFF_SG) + (size_t)MTOK * 1536; bf16_t* y1 = (bf16_t*)(ws + OFF_Y) + (size_t)MTOK * 768; float* stb = (float*)(ws + OFF_STB);
    const bf16_t* ktb = (const bf16_t*)(ws + OFF_KTB); const bf16_t* pgb = (const bf16_t*)(ws + OFF_PGB); const float* elast = (const float*)(ws + OFF_ELAST);
    LAS bf16_t* Qs = (LAS bf16_t*)lds; LAS bf16_t* KTs = Qs + 64 * 104; LAS bf16_t* VTs = KTs + 96 * 72; LAS bf16_t* Ss = VTs + 32 * 72; LAS bf16_t* STs = Ss + 64 * 72;
    LAS float* elS = (LAS float*)(STs + 32 * 104); LAS float* stx = elS + 96;
    f32x4 sacc[2]; sacc[0] = (f32x4){0.f, 0.f, 0.f, 0.f}; sacc[1] = (f32x4){0.f, 0.f, 0.f, 0.f};
    float st2[4];
    u32x4 pq[2], pk[2], ps; u32x2 pv; float pel = 0.f;
    const int st_t = tid >> 3, st_s8 = tid & 7, vs = tid >> 3, ve = (tid & 7) * 4;
#define GLA_PREFETCH(cc) do { const int ch_ = ((b * 64 + (cc)) * 4 + h); const int r0_ = b * SEQ + (cc) * 64; \
        _Pragma("unroll") for (int k_ = 0; k_ < 2; ++k_) { const int i_ = tid + NTHR * k_; if (i_ < 768) { const int t_ = i_ / 12, d8_ = i_ - t_ * 12; pq[k_] = *(const u32x4*)(bqk + (size_t)(r0_ + t_) * 768 + h * 96 + d8_ * 8); \
            pk[k_] = *(const u32x4*)(ktb + (size_t)ch_ * 6144 + (size_t)i_ * 8); } } \
        ps = *(const u32x4*)(pgb + (size_t)ch_ * 4096 + st_t * 64 + st_s8 * 8); \
        if (tid < 96) pel = elast[ch_ * 96 + tid]; \
        pv = *(const u32x2*)(y1 + (size_t)(r0_ + vs) * 768 + h * 192 + e0 + ve); } while (0)
    GLA_PREFETCH(0);
    __syncthreads();
    for (int c = 0; c < 64; ++c) {
        const int row0 = b * SEQ + c * 64;
        asm volatile("s_waitcnt vmcnt(0)" ::: "memory");
#pragma unroll
        for (int k = 0; k < 2; ++k) { const int i = tid + NTHR * k; if (i < 768) { const int t = i / 12, d8 = i - t * 12; *(LAS u32x4*)(Qs + t * 104 + d8 * 8) = pq[k];
            const int d = i >> 3, s8 = i & 7; *(LAS u32x4*)(KTs + d * 72 + s8 * 8) = pk[k]; } }
        *(LAS u32x4*)(Ss + st_t * 72 + st_s8 * 8) = ps;
        VTs[(ve + 0) * 72 + vs] = (bf16_t)(pv.x & 0xffffu); VTs[(ve + 1) * 72 + vs] = (bf16_t)(pv.x >> 16); VTs[(ve + 2) * 72 + vs] = (bf16_t)(pv.y & 0xffffu); VTs[(ve + 3) * 72 + vs] = (bf16_t)(pv.y >> 16);
        if (tid < 96) elS[tid] = pel;
        if (wid < 6) {
#pragma unroll
            for (int er = 0; er < 2; ++er)
#pragma unroll
                for (int r = 0; r < 4; ++r) STs[(16 * er + 4 * fq + r) * 104 + 16 * wid + fr] = f2bf(sacc[er][r]); }
        if (c > 0 && (wid & 1) == 0 && fr == 0) {
#pragma unroll
            for (int r = 0; r < 4; ++r) { const int tt = 16 * (wid >> 1) + 4 * fq + r; stb[((size_t)(row0 - 64 + tt) * 4 + h) * NSTAT + es] = st2[r] + stx[tt]; } }
        if (c + 1 < 64) GLA_PREFETCH(c + 1);
        __syncthreads();
        { const int tr = wid >> 1, ec = wid & 1; f32x4 o = (f32x4){0.f, 0.f, 0.f, 0.f};
          o = mma_tile<64>(Ss, 72, 16 * tr, VTs, 72, 16 * ec, o, lane);
          o = mma_tile<96>(Qs, 104, 16 * tr, STs, 104, 16 * ec, o, lane);
#pragma unroll
          for (int r = 0; r < 4; ++r) { const int tt = 16 * tr + 4 * fq + r; y1[(size_t)(row0 + tt) * 768 + h * 192 + e0 + 16 * ec + fr] = f2bf(o[r]);
              const float s2 = rowsum16(o[r] * o[r]);
              if (fr == 0) { if (ec) stx[tt] = s2; else st2[r] = s2; } } }
        if (wid < 6) { const float dec = elS[16 * wid + fr];
#pragma unroll
            for (int er = 0; er < 2; ++er) { sacc[er] = mma_tile<64>(VTs, 72, 16 * er, KTs, 72, 16 * wid, sacc[er], lane); sacc[er] = sacc[er] * dec; } }
        __syncthreads();
    }
    if ((wid & 1) == 0 && fr == 0) { const int row0 = b * SEQ + 63 * 64;
#pragma unroll
        for (int r = 0; r < 4; ++r) { const int tt = 16 * (wid >> 1) + 4 * fq + r; stb[((size_t)(row0 + tt) * 4 + h) * NSTAT + es] = st2[r] + stx[tt]; } }
    __syncthreads();
#undef GLA_PREFETCH
}


__device__ __forceinline__ void cmul(float ar, float ai, float br, float bi, float& cr, float& ci) { cr = ar * br - ai * bi; ci = ar * bi + ai * br; }
__device__ __forceinline__ void s5_item(LAS unsigned char* lds, const Params p, int layer, int item) {
    int tid_l = threadIdx.x; asm volatile("" : "+v"(tid_l)); const int tid = tid_l, lane = tid & 63, wid = __builtin_amdgcn_readfirstlane(tid >> 6), fr = lane & 15, fq = lane >> 4;
    const int g = item & 31, b = item >> 5; unsigned char* ws = p.ws;
    bf16_t* cu = (bf16_t*)(ws + OFF_CU);
    const float* lam_re = p.in[9] + (size_t)layer * 2048 + g * 64; const float* lam_im = p.in[10] + (size_t)layer * 2048 + g * 64; const float ldt = p.in[11][layer * 32 + g];
    const float* Bre = p.in[12] + ((size_t)layer * 32 + g) * 1024; const float* Bim = p.in[13] + ((size_t)layer * 32 + g) * 1024;
    const float* Cre = p.in[14] + ((size_t)layer * 32 + g) * 1024; const float* Cim = p.in[15] + ((size_t)layer * 32 + g) * 1024;
    const float dsk = p.in[16][layer * 512 + g * 16 + fr];
    LAS float* BU = (LAS float*)(lds + wid * 12288);
    LAS bf16_t* Xs = (LAS bf16_t*)(lds + wid * 12288 + 8192);
    LAS float* Es = (LAS float*)(lds + 8 * 12288);
    const float dt = __expf(ldt);
    float are, aim;
    { const float lr = fminf(lam_re[lane], -1e-4f), li = lam_im[lane]; const float mag = __expf(lr * dt); are = mag * cosf(li * dt); aim = mag * sinf(li * dt); }
    bf16x8 bbop[8];
#pragma unroll
    for (int ct = 0; ct < 8; ++ct) { const int pp = 16 * ct + fr, ps = pp >> 1, cc = pp & 1; float f[8];
        const float lr = fminf(lam_re[ps], -1e-4f), li = lam_im[ps]; const float mag = __expf(lr * dt); const float abr = mag * cosf(li * dt), abi = mag * sinf(li * dt);
        const float nr = abr - 1.0f, den = lr * lr + li * li; const float cre = (nr * lr + abi * li) / den, cim = (abi * lr - nr * li) / den;
#pragma unroll
        for (int j = 0; j < 8; ++j) { float v = 0.f; if (fq < 2) { const float br = Bre[ps * 16 + 8 * fq + j], bi = Bim[ps * 16 + 8 * fq + j]; v = cc ? (cre * bi + cim * br) : (cre * br - cim * bi); } f[j] = v; }
        const u32x4 w = pack8(f); bbop[ct] = *(const bf16x8*)&w; }
    bf16x8 cmop[4];
#pragma unroll
    for (int ks = 0; ks < 4; ++ks) { float f[8];
#pragma unroll
        for (int j = 0; j < 8; ++j) { const int pp = 32 * ks + 8 * fq + j, ps = pp >> 1; f[j] = (pp & 1) ? -Cim[fr * 64 + ps] : Cre[fr * 64 + ps]; }
        const u32x4 w = pack8(f); cmop[ks] = *(const bf16x8*)&w; }
    const int seg0 = b * SEQ + wid * 512;
    float xr = 0.f, xi = 0.f;
    for (int pass = 0; pass < 2; ++pass) {
        u32x4 aw_n = (u32x4){0u, 0u, 0u, 0u}; bf16_t uv_n[4] = {0, 0, 0, 0};
        if (fq < 2) aw_n = *(const u32x4*)(cu + (size_t)(seg0 + fr) * 512 + g * 16 + 8 * fq);
        if (pass) {
#pragma unroll
            for (int r = 0; r < 4; ++r) uv_n[r] = cu[(size_t)(seg0 + 4 * fq + r) * 512 + g * 16 + fr]; }
        float of[32];
        for (int tile4 = 0; tile4 < 4; ++tile4) {
#pragma unroll
        for (int tq = 0; tq < 8; ++tq) { const int tile = tile4 * 8 + tq;
            const int r0 = seg0 + tile * 16;
            asm volatile("s_waitcnt vmcnt(0)" ::: "memory");
            const u32x4 aw = aw_n; const bf16x8 aop = *(const bf16x8*)&aw; bf16_t uvc[4];
#pragma unroll
            for (int r = 0; r < 4; ++r) uvc[r] = uv_n[r];
            if (tile + 1 < 32) { if (fq < 2) aw_n = *(const u32x4*)(cu + (size_t)(r0 + 16 + fr) * 512 + g * 16 + 8 * fq);
                if (pass) {
#pragma unroll
                    for (int r = 0; r < 4; ++r) uv_n[r] = cu[(size_t)(r0 + 16 + 4 * fq + r) * 512 + g * 16 + fr]; } }
#pragma unroll
            for (int ct = 0; ct < 8; ++ct) { f32x4 a = (f32x4){0.f, 0.f, 0.f, 0.f}; a = __builtin_amdgcn_mfma_f32_16x16x32_bf16(aop, bbop[ct], a, 0, 0, 0);
#pragma unroll
                for (int r = 0; r < 4; ++r) BU[(4 * fq + r) * 128 + 16 * ct + fr] = a[r]; }
#pragma unroll
            for (int t = 0; t < 16; ++t) { const f32x2v bu = *(const LAS f32x2v*)(BU + t * 128 + 2 * lane); const float nr = are * xr - aim * xi + bu.x, ni = are * xi + aim * xr + bu.y; xr = nr; xi = ni;
                if (pass) *(LAS unsigned*)(Xs + t * 128 + 2 * lane) = cvt_pk_bf16(xr, xi); }
            if (pass) {
                f32x4 y = (f32x4){0.f, 0.f, 0.f, 0.f};
#pragma unroll
                for (int ks = 0; ks < 4; ++ks) { const bf16x8 xa = *(const LAS bf16x8*)(Xs + fr * 128 + 32 * ks + 8 * fq); y = __builtin_amdgcn_mfma_f32_16x16x32_bf16(xa, cmop[ks], y, 0, 0, 0); }
#pragma unroll
                for (int r = 0; r < 4; ++r) { const float uv = bf2f(uvc[r]); of[tq * 4 + r] = geluf_(y[r] + dsk * uv); }
            }
        }
        if (pass) {
#pragma unroll
            for (int tq = 0; tq < 8; ++tq)
#pragma unroll
                for (int r = 0; r < 4; ++r) cu[(size_t)(seg0 + (tile4 * 8 + tq) * 16 + 4 * fq + r) * 512 + g * 16 + fr] = f2bf(of[tq * 4 + r]); }
        }
        if (pass == 0) {
            Es[(wid * 64 + lane) * 2] = xr; Es[(wid * 64 + lane) * 2 + 1] = xi;
            __syncthreads();
            float pr = are, pi = aim;
#pragma unroll
            for (int i = 0; i < 9; ++i) { float tr, ti; cmul(pr, pi, pr, pi, tr, ti); pr = tr; pi = ti; }
            xr = 0.f; xi = 0.f;
            for (int w = 0; w < wid; ++w) { float tr, ti; cmul(pr, pi, xr, xi, tr, ti); xr = tr + Es[(w * 64 + lane) * 2]; xi = ti + Es[(w * 64 + lane) * 2 + 1]; }
        }
    }
    __syncthreads();
}

#define XB_TMO      128
#define XB_XCNT(j)  (256  + 64 * (j))
#define XB_XSUB(j)  (1280 + 64 * (j))
#define XB_XGEN(j)  (2304 + 64 * (j))
#define XB_TOP      3328
#define XB_TOPGEN   3392
#define XCD_BAR_WORDS 3456
#define XB_SPIN_CAP (1u << 18)

__device__ __forceinline__ unsigned xb_ld(unsigned* p)              { return __hip_atomic_load(p, __ATOMIC_RELAXED, __HIP_MEMORY_SCOPE_AGENT); }
__device__ __forceinline__ unsigned xb_add(unsigned* p, unsigned v) { return __hip_atomic_fetch_add(p, v, __ATOMIC_RELAXED, __HIP_MEMORY_SCOPE_AGENT); }
__device__ __forceinline__ unsigned xb_xcc_id() { return (unsigned)__builtin_amdgcn_s_getreg((3 << 11) | 20) & 0xFu; }
#define XB_SPIN(cond, bar) do { unsigned _sp = 0; while (cond) { __builtin_amdgcn_s_sleep(1); \
    if ((++_sp & 255u) == 0u) { if (xb_ld(&(bar)[XB_TMO])) break; if (_sp > XB_SPIN_CAP) { atomicAdd(&(bar)[XB_TMO], 1u); break; } } } } while (0)

struct XcdBarrier {
    unsigned* bar; unsigned x;
    volatile LAS unsigned* st;
};

__device__ __forceinline__ XcdBarrier xcd_barrier_post(unsigned* bar, volatile LAS unsigned* st) {
    XcdBarrier b; b.bar = bar; b.x = xb_xcc_id(); b.st = st;
    if (threadIdx.x == 0) (void)xb_add(&bar[XB_XCNT(b.x)], 1u);
    return b;
}
__device__ __forceinline__ void xcd_barrier_complete(unsigned* bar, unsigned x, unsigned& nloc, unsigned& nx) {
    const unsigned G = gridDim.x * gridDim.y * gridDim.z;
    unsigned sum, cnt, mine, sp = 0u;
    for (;;) {
        sum = 0u; cnt = 0u; mine = 0u;
#pragma unroll
        for (unsigned j = 0; j < 16; ++j) { const unsigned c = xb_ld(&bar[XB_XCNT(j)]); sum += c; cnt += (c > 0u) ? 1u : 0u; mine = (j == x) ? c : mine; }
        if (sum == G) break;
        __builtin_amdgcn_s_sleep(1);
        if ((++sp & 255u) == 0u) { if (xb_ld(&bar[XB_TMO])) break; if (sp > XB_SPIN_CAP) { atomicAdd(&bar[XB_TMO], 1u); break; } }
    }
    nloc = mine > 0u ? mine : 1u; nx = cnt > 0u ? cnt : 1u;
}

__device__ __forceinline__ void xcd_barrier(const XcdBarrier& b) {
    asm volatile("s_waitcnt vmcnt(0)" ::: "memory");
    __syncthreads();
    int xb_t0 = threadIdx.x; asm volatile("" : "+v"(xb_t0));
    if (xb_t0 == 0) {
        unsigned* bar = b.bar;
        __builtin_amdgcn_s_waitcnt(0);
        unsigned nloc = b.st[0], nx = b.st[1];
        if (nloc == 0u) { xcd_barrier_complete(bar, b.x, nloc, nx); b.st[0] = nloc; b.st[1] = nx; }
        const unsigned old = xb_add(&bar[XB_XSUB(b.x)], 1u);
        const unsigned gen = old / nloc;
        if (old + 1u == (gen + 1u) * nloc) {
            __builtin_amdgcn_fence(__ATOMIC_RELEASE, "agent");
            asm volatile("s_waitcnt vmcnt(0)" ::: "memory");
            const unsigned og = xb_add(&bar[XB_TOP], 1u);
            const unsigned tg = og / nx;
            if (og + 1u == (tg + 1u) * nx) xb_add(&bar[XB_TOPGEN], 1u);
            else XB_SPIN(xb_ld(&bar[XB_TOPGEN]) == tg, bar);
            __builtin_amdgcn_fence(__ATOMIC_ACQUIRE, "agent");
            xb_add(&bar[XB_XGEN(b.x)], 1u);
            asm volatile("s_waitcnt vmcnt(0)" ::: "memory");
        } else {
            XB_SPIN(xb_ld(&bar[XB_XGEN(b.x)]) == gen, bar);
            __builtin_amdgcn_fence(__ATOMIC_ACQUIRE, "agent");
            asm volatile("s_waitcnt vmcnt(0)" ::: "memory");
        }
    }
    __syncthreads();
}


__global__ void __launch_bounds__(NTHR, 2) hybrid_fwd(Params p0) {
    extern __shared__ __attribute__((aligned(16))) unsigned char lds_raw[];
    LAS unsigned char* lds = (LAS unsigned char*)lds_raw;
    cg::grid_group grid = cg::this_grid();
    if (p0.ws == nullptr) grid.sync();
    volatile LAS unsigned* xst = (volatile LAS unsigned*)(lds + 131072);
    if (threadIdx.x < 4) xst[threadIdx.x] = 0u;
    __syncthreads();
    const XcdBarrier xbar = xcd_barrier_post((unsigned*)(__attribute__((address_space(1))) unsigned*)(p0.ws + OFF_BAR), xst);
#define WSP(T, off) ((T*)(p.ws + (off)))
    { Params q = p0; q.ws = (unsigned char*)(__attribute__((address_space(1))) unsigned char*)p0.ws; q.in[0] = (const float*)(__attribute__((address_space(1))) const float*)p0.in[0]; q.in[1] = (const float*)(__attribute__((address_space(1))) const float*)p0.in[1]; phase_prologue_x(q); }
#pragma nounroll
    for (int ph = 0; ph < 14; ++ph) {
        int phl = ph; asm volatile("" : "+s"(phl));
        const int layer = phl >= 7 ? 1 : 0, k = phl - 7 * layer;
        int G_l = gridDim.x, c_l = blockIdx.x; asm volatile("" : "+s"(G_l), "+s"(c_l)); const int G = G_l, c = c_l;
        Params q = p0; { unsigned lo = (unsigned)((size_t)p0.ws), hi = (unsigned)((size_t)p0.ws >> 32); asm volatile("" : "+v"(lo), "+v"(hi)); lo = __builtin_amdgcn_readfirstlane(lo); hi = __builtin_amdgcn_readfirstlane(hi); q.ws = (unsigned char*)(__attribute__((address_space(1))) unsigned char*)(((size_t)hi << 32) | (size_t)lo);
#pragma unroll
          for (int i = 0; i < 23; ++i) q.in[i] = (const float*)(__attribute__((address_space(1))) const float*)p0.in[i];
          q.out = (float*)(__attribute__((address_space(1))) float*)p0.out; }
        const Params p = q; int ztid = threadIdx.x; asm volatile("" : "+v"(ztid));
#ifdef PROBE_K
        const unsigned long long tp0 = __builtin_amdgcn_s_memrealtime();
#endif
        switch (k) {
        case 0: phase_convert(lds, p, layer); break;
        case 1: {
            pg8::Gemm g{WSP(bf16_t, OFF_XW), WSP(bf16_t, OFF_W1A), MTOK, N1A, 1024}; pg8::StaticOrder S; S.init(MTOK, N1A, G, c);
            EpiG1a E{WSP(float, OFF_RSTD), WSP(bf16_t, OFF_SG), WSP(bf16_t, OFF_SG) + (size_t)MTOK * 1536, WSP(bf16_t, OFF_Y), WSP(bf16_t, OFF_Y) + (size_t)MTOK * 768, WSP(bf16_t, OFF_CU), WSP(bf16_t, OFF_SCZ), WSP(float, OFF_SMALL)};
            pg8::gemm_phase<EpiG1a, pg8::StaticOrder, false>(lds, g, S, E, nullptr); } break;
        case 2:
            for (int it = c; it < 2048; it += G) { if (it < 1024) mlstm_pre(lds, p, layer, it); else gla_pre(lds, p, layer, it - 1024); } break;
        case 3:
            for (int it = c; it < 256; it += G) {
                if (it < 96) mlstm_item(lds, p, layer, it);
                else if (it < 192) gla_item(lds, p, layer, it - 96);
                else { for (int k5 = 0; k5 < 2; ++k5) s5_item(lds, p, layer, it - 192 + 64 * k5); }
            } break;
        case 4: {
            { bf16_t* y2 = WSP(bf16_t, OFF_Y2); for (size_t i = (size_t)c * NTHR + ztid; i < (size_t)MTOK * 32; i += (size_t)G * NTHR) { const size_t row = i >> 5, seg = i & 31; *(u32x4*)(y2 + row * 768 + 512 + seg * 8) = (u32x4){0u, 0u, 0u, 0u}; } }
            { pg8::Gemm g{WSP(bf16_t, OFF_XW), WSP(bf16_t, OFF_W1B), MTOK, N1B, 1024}; pg8::StaticOrder S; S.init(MTOK, N1B, G, c);
              EpiG1b E{WSP(float, OFF_RSTD), WSP(bf16_t, OFF_Y), WSP(bf16_t, OFF_Y) + (size_t)MTOK * 768, WSP(bf16_t, OFF_SG), WSP(float, OFF_STA), WSP(float, OFF_STB), p.in[5] + (size_t)layer * 768, p.in[8] + (size_t)layer * 768};
              pg8::gemm_phase<EpiG1b, pg8::StaticOrder, false>(lds, g, S, E, nullptr); }
            { int Gl = G; asm volatile("" : "+s"(Gl)); const bool split = (Gl == 256); const int g2G = split ? 128 : G, g2c = split ? c - 128 : c;
              if (g2c >= 0) { pg8::Gemm g{WSP(bf16_t, OFF_CU), WSP(bf16_t, OFF_WGLU), MTOK, 512, 512}; pg8::StaticOrder S; S.init(MTOK, 512, g2G, g2c);
                  EpiG2 E{WSP(bf16_t, OFF_CU), WSP(bf16_t, OFF_SCZ), WSP(bf16_t, OFF_Y2)};
                  pg8::gemm_phase<EpiG2, pg8::StaticOrder, false>(lds, g, S, E, nullptr); } } } break;
        case 5: {
            pg8::Gemm g{WSP(bf16_t, OFF_Y), WSP(bf16_t, OFF_WBR), 3 * MTOK, 3 * 1024, 768}; BranchOrder S{G, c}; EpiG3 E{WSP(bf16_t, OFF_SG), WSP(bf16_t, OFF_MERGED)};
            pg8::gemm_phase<EpiG3, BranchOrder, false>(lds, g, S, E, nullptr); } break;
        default: {
            pg8::Gemm g{WSP(bf16_t, OFF_MERGED), WSP(bf16_t, OFF_WOUT), MTOK, 1024, 1024}; pg8::StaticOrder S; S.init(MTOK, 1024, G, c);
            EpiG4 E{layer == 0 ? p.in[0] : p.out, p.out, WSP(bf16_t, OFF_XW), layer == 0 ? p.in[1] + 1024 : p.in[22], WSP(float, OFF_RSS), layer == 0 ? 1 : 0};
            pg8::gemm_phase<EpiG4, pg8::StaticOrder, false>(lds, g, S, E, nullptr); } break;
        }
#ifdef PROBE_K
        if (k == PROBE_K) { const unsigned long long tp1 = __builtin_amdgcn_s_memrealtime(); while (__builtin_amdgcn_s_memrealtime() - tp1 < tp1 - tp0) __builtin_amdgcn_s_sleep(8); }
#endif
        xcd_barrier(xbar);
    }
    { Params p = p0; p.ws = (unsigned char*)(__attribute__((address_space(1))) unsigned char*)p0.ws; p.out = (float*)(__attribute__((address_space(1))) float*)p0.out; p.in[22] = (const float*)(__attribute__((address_space(1))) const float*)p0.in[22]; const int G = gridDim.x, c = blockIdx.x; int tid_l = threadIdx.x; asm volatile("" : "+v"(tid_l)); const int tid = tid_l, lane = tid & 63, wid = tid >> 6; const float* fn = p.in[22]; const float* RSS = WSP(float, OFF_RSS);
      f32x4 nv[4];
#pragma unroll
      for (int i = 0; i < 4; ++i) nv[i] = *(const f32x4*)(fn + i * 256 + lane * 4);
      for (int row = c * 8 + wid; row < MTOK; row += G * 8) { const float rs = row_rstd(RSS, row);
#pragma unroll
          for (int i = 0; i < 4; ++i) { float* op = p.out + (size_t)row * 1024 + i * 256 + lane * 4; const f32x4 v = *(const f32x4*)op; *(f32x4*)op = v * rs * nv[i]; } } }
#undef WSP
}

extern "C" void kernel_launch(void* const* d_in, const int* in_sizes, int n_in, void* d_out, int out_size, void* d_ws, size_t ws_size, hipStream_t stream) {
    static int grid_blocks = 0;
    if (grid_blocks == 0) {
        if (n_in != 23 || ws_size < WS_END) { fprintf(stderr, "kernel_launch: need 23 inputs and %zu bytes of workspace (got %d, %zu)\n", (size_t)WS_END, n_in, ws_size); grid_blocks = -1; return; }
        int dev = 0, cus = 0, per_cu = 0;
        hipGetDevice(&dev); hipDeviceGetAttribute(&cus, hipDeviceAttributeMultiprocessorCount, dev);
        if (hipFuncSetAttribute((const void*)hybrid_fwd, hipFuncAttributeMaxDynamicSharedMemorySize, LDS_BYTES) != hipSuccess) { fprintf(stderr, "kernel_launch: hipFuncSetAttribute failed\n"); grid_blocks = -1; return; }
        if (hipOccupancyMaxActiveBlocksPerMultiprocessor(&per_cu, (const void*)hybrid_fwd, NTHR, LDS_BYTES) != hipSuccess || per_cu < 1) per_cu = 1;
        (void)hipGetLastError();
        grid_blocks = cus * 1;
    }
    if (grid_blocks < 0) return;
    Params p{};
    for (int i = 0; i < 23; ++i) p.in[i] = (const float*)d_in[i];
    p.out = (float*)d_out; p.ws = (unsigned char*)d_ws;
    if (hipMemsetAsync((char*)d_ws + OFF_BAR, 0, BAR_BYTES, stream) != hipSuccess) { fprintf(stderr, "memset failed\n"); return; }
    void* args[] = {&p};
    hipError_t e = hipLaunchCooperativeKernel((const void*)hybrid_fwd, dim3(grid_blocks), dim3(NTHR), args, LDS_BYTES, stream);
    if (e != hipSuccess) fprintf(stderr, "cooperative launch failed: %s (grid %d)\n", hipGetErrorString(e), grid_blocks);
}
```

```cpp
#include <hip/hip_runtime.h>
#include <hip/hip_cooperative_groups.h>
#include <cstdio>
namespace cg = cooperative_groups;
namespace pg8 {
#define PG8_LAS __attribute__((address_space(3)))
typedef unsigned short bf16_t;
typedef short bf16x8 __attribute__((ext_vector_type(8)));
typedef float f32x4 __attribute__((ext_vector_type(4)));
typedef unsigned u32x4 __attribute__((ext_vector_type(4)));
constexpr int BM = 256, BK = 64, HALF = 128, HTB = HALF * BK * 2  , STAGE_BYTES = 8 * HTB, NXCD = 8, WGM = 8;

__host__ __device__ __forceinline__ int lds_byte(int r, int c) { const int st = (r >> 4) * 2 + (c >> 5), rr = r & 15, cc = c & 31, ob = rr * 64 + cc * 2; return st * 1024 + (ob ^ (((ob >> 9) & 1) << 5)); }
__host__ __device__ __forceinline__ void stage_rc(int b, int& R, int& C) { const int st = b / 1024, sb = b % 1024, swz = sb ^ (((sb >> 9) & 1) << 5); R = (st >> 1) * 16 + swz / 64; C = (st & 1) * 32 + (swz % 64) / 2; }
__host__ __device__ __forceinline__ int perm32(int rho) { const int n = rho >> 4, i = rho & 15; return 8 * (i >> 2) + 4 * n + (i & 3); }

struct Unit { int pm, pn; };
struct Gemm { const bf16_t* A; const bf16_t* Bt; int M, N, K; };

struct StaticOrder {
    int nM, nN, nwg, G, c;
    __host__ __device__ void init(int M, int N, int G_, int c_) { nM = M / BM; nN = N / BM; nwg = nM * nN; G = G_; c = c_; }
    __host__ __device__ bool next(int i, Unit& u) const {
        const long L = (long)i * G + c; if (L >= nwg) return false;
        int wgid = (int)L; { const int q = nwg / NXCD, r = nwg % NXCD, xcd = wgid % NXCD, off = wgid / NXCD; wgid = (xcd < r ? xcd * (q + 1) : r * (q + 1) + (xcd - r) * q) + off; }
        const int nig = WGM * nN, gid = wgid / nig, fm = gid * WGM, gsz = (nM - fm) < WGM ? (nM - fm) : WGM;
        u.pm = fm + ((wgid % nig) % gsz); u.pn = (wgid % nig) / gsz; return true;
    }
    __device__ __forceinline__ void a_ready(const Unit&) const {}
    __device__ __forceinline__ void done(const Unit&) const {}
};
typedef float f32x2c __attribute__((ext_vector_type(2)));
typedef __bf16 bf16x2c __attribute__((ext_vector_type(2)));
__device__ __forceinline__ unsigned cvt_pk_bf16(float lo, float hi) { const f32x2c v = {lo, hi}; const bf16x2c r = __builtin_convertvector(v, bf16x2c); return __builtin_bit_cast(unsigned, r); }
typedef float f32x2 __attribute__((ext_vector_type(2)));
template <class Epi, class Sched, bool STAMP = false>
__device__ __forceinline__ void gemm_phase(PG8_LAS unsigned char* lds, const Gemm g, const Sched& S, const Epi& E, unsigned long long* stamps) {
    int tid_l = threadIdx.x; asm volatile("" : "+v"(tid_l)); const int tid = tid_l, wid = __builtin_amdgcn_readfirstlane(tid >> 6), lane = tid & 63, wr = wid >> 2, wc = wid & 3, fr = lane & 15, fq = lane >> 4;
    const int K = g.K, nt = K / BK;
    int ts_lo = 0, ts_hi = 0, nts = 0; const unsigned long long rt_entry = STAMP ? (unsigned long long)wall_clock64() : 0ull;
#define PG8_STAMP() do { if (STAMP && wid == 0 && nts < 64) { const unsigned long long _c = (unsigned long long)clock64(); \
        ts_lo = (lane == nts) ? (int)(unsigned)_c : ts_lo; ts_hi = (lane == nts) ? (int)(unsigned)(_c >> 32) : ts_hi; ++nts; } } while (0)
    PG8_STAMP();
    unsigned voffA[2], voffB[2];
#pragma unroll
    for (int i = 0; i < 2; ++i) { int R, C; stage_rc(tid * 16 + i * 8192, R, C); const int Rb = Epi::PERM ? ((R & ~31) + perm32(R & 31)) : R;
        voffA[i] = (unsigned)(R * K + C) * 2u; voffB[i] = (unsigned)(Rb * K + C) * 2u; }
    const size_t kstep = (size_t)(BK * 2);
    const size_t hstep = (size_t)HALF * K * 2;
    const size_t tstep = 2 * hstep;
    const unsigned ldsw = (unsigned)wid * 1024u;
    const int aoff = lds_byte(wr * 64 + fr, fq * 8), boff = lds_byte(wc * 32 + fr, fq * 8);
#define PG8_SA(b, h) (((b) * 2 + (h)) * HTB)
#define PG8_SB(b, h) ((4 + (b) * 2 + (h)) * HTB)
#define PG8_STAGE(bufoff, gbase, voff) do { _Pragma("unroll") for (int _i = 0; _i < 2; ++_i) \
        __builtin_amdgcn_global_load_lds((const unsigned*)((const char*)(gbase) + (voff)[_i]), (PG8_LAS unsigned*)(lds + (bufoff) + ldsw + _i * 8192), 16, 0, 0); } while (0)
#define PG8_LDA(dst, b, h) do { _Pragma("unroll") for (int m = 0; m < 4; ++m) _Pragma("unroll") for (int k = 0; k < 2; ++k) dst[m][k] = *(const PG8_LAS bf16x8*)(lds + PG8_SA(b, h) + aoff + m * 2048 + k * 1024); } while (0)
#define PG8_LDB(dst, b, h) do { _Pragma("unroll") for (int n = 0; n < 2; ++n) _Pragma("unroll") for (int k = 0; k < 2; ++k) dst[n][k] = *(const PG8_LAS bf16x8*)(lds + PG8_SB(b, h) + boff + n * 2048 + k * 1024); } while (0)
#define PG8_MMA(ai, bj, At, Bt) do { __builtin_amdgcn_s_setprio(1); _Pragma("unroll") for (int m = 0; m < 4; ++m) _Pragma("unroll") for (int n = 0; n < 2; ++n) _Pragma("unroll") for (int k = 0; k < 2; ++k) \
        acc[ai][bj][m][n] = __builtin_amdgcn_mfma_f32_16x16x32_bf16(Bt[n][k], At[m][k], acc[ai][bj][m][n], 0, 0, 0); __builtin_amdgcn_s_setprio(0); } while (0)
#define PG8_WAIT_V(n) asm volatile("s_waitcnt vmcnt(" #n ")" ::: "memory")
#define PG8_WAIT_L(n) asm volatile("s_waitcnt lgkmcnt(" #n ")" ::: "memory")
#define PG8_BAR __builtin_amdgcn_s_barrier()
#define PG8_SCHED __builtin_amdgcn_sched_barrier(0)
    Unit cur, nxt; int ui = 0;
    if (!S.next(0, cur)) return;
    f32x4 acc[2][2][4][2];
#pragma unroll
    for (int a = 0; a < 2; ++a)
#pragma unroll
        for (int b = 0; b < 2; ++b)
#pragma unroll
            for (int m = 0; m < 4; ++m)
#pragma unroll
                for (int n = 0; n < 2; ++n) acc[a][b][m][n] = (f32x4){0.f, 0.f, 0.f, 0.f};
    bf16x8 At[4][2], B0[2][2], B1[2][2];
    const char* cA = (const char*)g.A + (size_t)cur.pm * tstep; const char* cB = (const char*)g.Bt + (size_t)cur.pn * tstep;
    S.a_ready(cur);
    PG8_STAGE(PG8_SB(0, 0), cB, voffB); PG8_STAGE(PG8_SA(0, 0), cA, voffA); PG8_STAGE(PG8_SB(0, 1), cB + hstep, voffB); PG8_STAGE(PG8_SA(0, 1), cA + hstep, voffA);
    if (wr == 1) PG8_BAR;
    PG8_WAIT_V(4); PG8_BAR;
    PG8_STAGE(PG8_SB(1, 0), cB + kstep, voffB); PG8_STAGE(PG8_SA(1, 0), cA + kstep, voffA); PG8_STAGE(PG8_SB(1, 1), cB + hstep + kstep, voffB);
    PG8_WAIT_V(6); PG8_BAR;
    PG8_STAMP();
    for (;;) {
        const bool has_next = S.next(ui + 1, nxt);
        const char* nA = has_next ? (const char*)g.A + (size_t)nxt.pm * tstep : cA; const char* nB = has_next ? (const char*)g.Bt + (size_t)nxt.pn * tstep : cB;
        for (int t = 0; t < nt; t += 2) {
            const bool last = (t == nt - 2);
            const char* a1 = cA + (size_t)(t + 1) * kstep;
            const char* a2 = last ? nA : cA + (size_t)(t + 2) * kstep; const char* b2 = last ? nB : cB + (size_t)(t + 2) * kstep;
            const char* a3 = a2 + kstep; const char* b3 = b2 + kstep;
            if (last && has_next) S.a_ready(nxt);
            PG8_LDB(B0, 0, 0); PG8_SCHED; PG8_LDA(At, 0, 0); PG8_STAGE(PG8_SA(1, 1), a1 + hstep, voffA);
            PG8_WAIT_L(8); PG8_BAR; PG8_WAIT_L(0); PG8_MMA(0, 0, At, B0); PG8_BAR; PG8_SCHED;
            PG8_LDB(B1, 0, 1); PG8_STAGE(PG8_SB(0, 0), b2, voffB);
            PG8_BAR; PG8_WAIT_L(0); PG8_MMA(0, 1, At, B1); PG8_BAR;
            PG8_LDA(At, 0, 1); PG8_STAGE(PG8_SA(0, 0), a2, voffA);
            PG8_BAR; PG8_WAIT_L(0); PG8_MMA(1, 0, At, B0); PG8_BAR; PG8_SCHED;
            PG8_STAGE(PG8_SB(0, 1), b2 + hstep, voffB);
            PG8_WAIT_V(6); PG8_BAR; PG8_MMA(1, 1, At, B1); PG8_BAR;
            PG8_LDB(B0, 1, 0); PG8_SCHED; PG8_LDA(At, 1, 0); PG8_STAGE(PG8_SA(0, 1), a2 + hstep, voffA);
            PG8_WAIT_L(8); PG8_BAR; PG8_WAIT_L(0); PG8_MMA(0, 0, At, B0); PG8_BAR; PG8_SCHED;
            PG8_LDB(B1, 1, 1); PG8_STAGE(PG8_SB(1, 0), b3, voffB);
            PG8_BAR; PG8_WAIT_L(0); PG8_MMA(0, 1, At, B1); PG8_BAR;
            PG8_LDA(At, 1, 1); PG8_STAGE(PG8_SA(1, 0), a3, voffA);
            PG8_BAR; PG8_WAIT_L(0); PG8_MMA(1, 0, At, B0); PG8_BAR; PG8_SCHED;
            PG8_STAGE(PG8_SB(1, 1), b3 + hstep, voffB);
            PG8_WAIT_V(6); PG8_BAR; PG8_MMA(1, 1, At, B1); PG8_BAR;
        }
        PG8_STAMP();
        if constexpr (!Epi::AFTER_DRAIN) { E(acc, cur, wr, wc, fr, fq); S.done(cur); }
        PG8_STAMP();
        if (!has_next) break;
#pragma unroll
        for (int a = 0; a < 2; ++a)
#pragma unroll
            for (int b = 0; b < 2; ++b)
#pragma unroll
                for (int m = 0; m < 4; ++m)
#pragma unroll
                    for (int n = 0; n < 2; ++n) acc[a][b][m][n] = (f32x4){0.f, 0.f, 0.f, 0.f};
        cur = nxt; cA = nA; cB = nB; ++ui;
    }
    PG8_WAIT_V(0);
    if (wr == 0) PG8_BAR;
    PG8_BAR;
    if constexpr (Epi::AFTER_DRAIN) { E.fused(acc, cur, wr, wc, fr, fq, lds, wid, lane); S.done(cur); }
    PG8_STAMP();
    if (STAMP && wid == 0) { stamps[lane] = lane < nts ? (((unsigned long long)(unsigned)ts_hi << 32) | (unsigned)ts_lo) : 0ull;
        if (lane == 62) stamps[62] = rt_entry; if (lane == 63) stamps[63] = (unsigned long long)wall_clock64(); }
#undef PG8_STAMP
#undef PG8_SA
#undef PG8_SB
#undef PG8_STAGE
#undef PG8_LDA
#undef PG8_LDB
#undef PG8_MMA
#undef PG8_WAIT_V
#undef PG8_WAIT_L
#undef PG8_BAR
#undef PG8_SCHED
}
}

#define LAS __attribute__((address_space(3)))
using pg8::bf16_t; using pg8::bf16x8; using pg8::f32x4; using pg8::u32x4; using pg8::Unit; using pg8::cvt_pk_bf16;
typedef unsigned u32x2 __attribute__((ext_vector_type(2)));
typedef float f32x2v __attribute__((ext_vector_type(2)));

constexpr int MTOK = 16384, DM = 1024, SEQ = 4096;
constexpr int NTHR = 512;
constexpr int LDS_BYTES = 131072 + 16;
constexpr int N1A = 5120, N1B = 5376;
constexpr int NSTAT = 6;
constexpr int NSTA = 2;

constexpr size_t OFF_W1A = 0;
constexpr size_t OFF_W1B = OFF_W1A + (size_t)N1A * 1024 * 2;
constexpr size_t OFF_WGLU = OFF_W1B + (size_t)N1B * 1024 * 2;
constexpr size_t OFF_WBR = OFF_WGLU + (size_t)512 * 512 * 2;
constexpr size_t OFF_WOUT = OFF_WBR + (size_t)3 * 1024 * 768 * 2;
constexpr size_t OFF_XW = OFF_WOUT + (size_t)1024 * 1024 * 2;
constexpr size_t OFF_RSS = OFF_XW + (size_t)MTOK * 1024 * 2;
constexpr size_t OFF_Y = OFF_RSS + (size_t)MTOK * 16 * 4;
constexpr size_t OFF_SG = OFF_Y + (size_t)3 * MTOK * 768 * 2;
constexpr size_t OFF_CU = OFF_SG + (size_t)MTOK * 3072 * 2;
constexpr size_t OFF_SCZ = OFF_CU + (size_t)MTOK * 512 * 2;
constexpr size_t OFF_SMALL = OFF_SCZ + (size_t)MTOK * 512 * 2;
constexpr size_t OFF_MERGED = OFF_SMALL + (size_t)MTOK * 32 * 4;
constexpr size_t OFF_STA = OFF_MERGED + (size_t)MTOK * 1024 * 2;
constexpr size_t OFF_STB = OFF_STA + (size_t)MTOK * 4 * NSTAT * 2 * 4;
constexpr size_t OFF_RSTD = OFF_STB + (size_t)MTOK * 4 * NSTAT * 4;
constexpr size_t OFF_BAR = OFF_RSTD + (size_t)MTOK * 4;
constexpr size_t BAR_BYTES = 16384;
constexpr size_t OFF_VG = OFF_BAR + BAR_BYTES;
constexpr int VGC = 42;
constexpr size_t WS_END = OFF_VG + (size_t)4 * VGC * 4 * 64 * 192 * 2;

struct Params { const float* in[23]; float* out; unsigned char* ws; };

__device__ __forceinline__ float bf2f(unsigned v) { return __uint_as_float(v << 16); }
__device__ __forceinline__ bf16_t f2bf(float f) { unsigned u = __float_as_uint(f); u += 0x7FFFu + ((u >> 16) & 1u); return (bf16_t)(u >> 16); }
__device__ __forceinline__ float sigmoidf_(float x) { return __builtin_amdgcn_rcpf(1.0f + __expf(-x)); }
__device__ __forceinline__ float siluf_(float x) { return x * sigmoidf_(x); }
__device__ __forceinline__ float logsigmoidf_(float x) { return fminf(x, 0.0f) - log1pf(__expf(-fabsf(x))); }
__device__ __forceinline__ float geluf_(float x) { const float u = 0.7978845608028654f * (x + 0.044715f * x * x * x); const float t = 1.0f - 2.0f * __builtin_amdgcn_rcpf(1.0f + __expf(2.0f * u)); return 0.5f * x * (1.0f + t); }
__device__ __forceinline__ void unpack8(const u32x4 w, float (&f)[8]) {
    f[0] = __uint_as_float(w.x << 16); f[1] = __uint_as_float(w.x & 0xffff0000u); f[2] = __uint_as_float(w.y << 16); f[3] = __uint_as_float(w.y & 0xffff0000u);
    f[4] = __uint_as_float(w.z << 16); f[5] = __uint_as_float(w.z & 0xffff0000u); f[6] = __uint_as_float(w.w << 16); f[7] = __uint_as_float(w.w & 0xffff0000u);
}
__device__ __forceinline__ u32x4 pack8(const float (&f)[8]) { u32x4 w; w.x = cvt_pk_bf16(f[0], f[1]); w.y = cvt_pk_bf16(f[2], f[3]); w.z = cvt_pk_bf16(f[4], f[5]); w.w = cvt_pk_bf16(f[6], f[7]); return w; }
__device__ __forceinline__ float row_rstd(const float* rss, int row) {
    const f32x4* p = (const f32x4*)(rss + (size_t)row * 16); const f32x4 a = p[0], b = p[1], c = p[2], d = p[3];
    const float s = ((a[0] + a[1]) + (a[2] + a[3])) + ((b[0] + b[1]) + (b[2] + b[3])) + ((c[0] + c[1]) + (c[2] + c[3])) + ((d[0] + d[1]) + (d[2] + d[3]));
    return rsqrtf(s * (1.0f / 1024.0f) + 1e-6f);
}

struct EpiG1a {
    static constexpr bool PERM = true, AFTER_DRAIN = false;
    const float* rss; bf16_t* aqk; bf16_t* bqk; bf16_t* y0; bf16_t* y1; bf16_t* cu; bf16_t* scz; float* small;
    __device__ __forceinline__ void operator()(const f32x4 (&acc)[2][2][4][2], const Unit& u, int wr, int wc, int fr, int fq) const {
        const int pn = u.pn; const int row0 = u.pm * 256 + wr * 64 + fr;
        if (pn == 19) {
            if (wc == 0) {
#pragma unroll
                for (int ai = 0; ai < 2; ++ai)
#pragma unroll
                    for (int m = 0; m < 4; ++m) { const int row = row0 + ai * 128 + m * 16; const float rs = rss[row]; float* rp = small + (size_t)row * 32 + 8 * fq;
                        *(f32x4*)(rp) = acc[ai][0][m][0] * rs; *(f32x4*)(rp + 4) = acc[ai][0][m][1] * rs; }
            }
            return;
        }
        bf16_t* base; int ldc, colt; bool act = false;
        if (pn < 6) { base = aqk; ldc = 1536; colt = pn * 256; }
        else if (pn < 9) { base = y0; ldc = 768; colt = (pn - 6) * 256; }
        else if (pn < 12) { base = bqk; ldc = 768; colt = (pn - 9) * 256; }
        else if (pn < 15) { base = y1; ldc = 768; colt = (pn - 12) * 256; }
        else if (pn < 17) { base = cu; ldc = 512; colt = (pn - 15) * 256; }
        else { base = scz; ldc = 512; colt = (pn - 17) * 256; act = true; }
        const int col0 = colt + wc * 32 + 8 * fq;
        float rs8[2][4];
#pragma unroll
        for (int ai = 0; ai < 2; ++ai)
#pragma unroll
            for (int m = 0; m < 4; ++m) rs8[ai][m] = rss[row0 + ai * 128 + m * 16];
        asm volatile("s_waitcnt vmcnt(0)" ::: "memory");
#pragma unroll
        for (int ai = 0; ai < 2; ++ai)
#pragma unroll
            for (int m = 0; m < 4; ++m) { const int row = row0 + ai * 128 + m * 16; const float rs = rs8[ai][m]; bf16_t* rowp = base + (size_t)row * ldc + col0;
#pragma unroll
                for (int bj = 0; bj < 2; ++bj) { f32x4 v0 = acc[ai][bj][m][0] * rs, v1 = acc[ai][bj][m][1] * rs;
                    if (act) {
#pragma unroll
                        for (int j = 0; j < 4; ++j) { v0[j] = siluf_(v0[j]); v1[j] = siluf_(v1[j]); } }
                    u32x4 w; w.x = cvt_pk_bf16(v0[0], v0[1]); w.y = cvt_pk_bf16(v0[2], v0[3]); w.z = cvt_pk_bf16(v1[0], v1[1]); w.w = cvt_pk_bf16(v1[2], v1[3]);
                    *(u32x4*)(rowp + bj * 128) = w; } }
    }
};
struct EpiG1b {
    static constexpr bool PERM = true, AFTER_DRAIN = false;
    const float* rss; bf16_t* y0; bf16_t* y1; bf16_t* sg; const float* sta; const float* stb; const float* anorm; const float* bnorm;
    __device__ __forceinline__ void operator()(const f32x4 (&acc)[2][2][4][2], const Unit& u, int wr, int wc, int fr, int fq) const {
        const int pn = u.pn; const int row0 = u.pm * 256 + wr * 64 + fr;
        if (pn < 6) {
            const int ch = pn * 128 + wc * 32 + 8 * fq, hd = ch / 192;
            float rs8[2][4];
#pragma unroll
            for (int ai = 0; ai < 2; ++ai)
#pragma unroll
                for (int m = 0; m < 4; ++m) rs8[ai][m] = rss[row0 + ai * 128 + m * 16];
            asm volatile("s_waitcnt vmcnt(0)" ::: "memory");
            u32x4 tk[2][4];
#pragma unroll
            for (int ai = 0; ai < 2; ++ai)
#pragma unroll
                for (int m = 0; m < 4; ++m) { const float rs = rs8[ai][m]; const f32x4 o0 = acc[ai][0][m][0] * rs, o1 = acc[ai][0][m][1] * rs, z0 = acc[ai][1][m][0] * rs, z1 = acc[ai][1][m][1] * rs; float t[8];
#pragma unroll
                    for (int j = 0; j < 4; ++j) { t[j] = sigmoidf_(o0[j]) * siluf_(z0[j]); t[4 + j] = sigmoidf_(o1[j]) * siluf_(z1[j]); }
                    tk[ai][m] = pack8(t); }
            asm volatile("" ::: "memory");
            float nw[8];
            { const f32x4 a = *(const f32x4*)(anorm + ch), b = *(const f32x4*)(anorm + ch + 4); nw[0] = a[0]; nw[1] = a[1]; nw[2] = a[2]; nw[3] = a[3]; nw[4] = b[0]; nw[5] = b[1]; nw[6] = b[2]; nw[7] = b[3]; }
#pragma unroll
            for (int ai = 0; ai < 2; ++ai) { f32x4 st4[4]; u32x4 hv4[4];
#pragma unroll
                for (int m = 0; m < 4; ++m) { const int row = row0 + ai * 128 + m * 16; st4[m] = *(const f32x4*)(sta + ((size_t)row * 4 + hd) * (NSTA * 2)); hv4[m] = *(const u32x4*)(y0 + (size_t)row * 768 + ch); }
                asm volatile("s_waitcnt vmcnt(0)" ::: "memory");
#pragma unroll
                for (int m = 0; m < 4; ++m) { const int row = row0 + ai * 128 + m * 16; const float s1 = st4[m][0] + st4[m][2], s2 = st4[m][1] + st4[m][3];
                    const float mean = s1 * (1.0f / 192.0f); const float var = fmaxf(s2 * (1.0f / 192.0f) - mean * mean, 0.0f); const float hr = rsqrtf(var + 1e-6f);
                    float hv[8], t[8], r[8]; unpack8(hv4[m], hv); unpack8(tk[ai][m], t);
#pragma unroll
                    for (int j = 0; j < 8; ++j) r[j] = t[j] * ((hv[j] - mean) * hr * nw[j]);
                    *(u32x4*)(y0 + (size_t)row * 768 + ch) = pack8(r); }
                asm volatile("" ::: "memory"); }
        } else if (pn < 9) {
#pragma unroll
            for (int bj = 0; bj < 2; ++bj) { const int ch = (pn - 6) * 256 + bj * 128 + wc * 32 + 8 * fq, hd = ch / 192;
                float nw[8];
                { const f32x4 a = *(const f32x4*)(bnorm + ch), b = *(const f32x4*)(bnorm + ch + 4); nw[0] = a[0]; nw[1] = a[1]; nw[2] = a[2]; nw[3] = a[3]; nw[4] = b[0]; nw[5] = b[1]; nw[6] = b[2]; nw[7] = b[3]; }
#pragma unroll
                for (int ai = 0; ai < 2; ++ai)
#pragma unroll
                    for (int m = 0; m < 4; ++m) { const int row = row0 + ai * 128 + m * 16; const float rs = rss[row];
                        const f32x2v* sp = (const f32x2v*)(stb + ((size_t)row * 4 + hd) * NSTAT); float s2 = 0.f;
#pragma unroll
                        for (int q = 0; q < NSTAT / 2; ++q) { const f32x2v t = sp[q]; s2 += t[0] + t[1]; }
                        const float hr = rsqrtf(s2 * (1.0f / 192.0f) + 1e-6f);
                        bf16_t* yp = y1 + (size_t)row * 768 + ch; float hv[8]; unpack8(*(const u32x4*)yp, hv);
                        const f32x4 z0 = acc[ai][bj][m][0] * rs, z1 = acc[ai][bj][m][1] * rs; float r[8];
#pragma unroll
                        for (int j = 0; j < 4; ++j) { r[j] = siluf_(z0[j]) * (hv[j] * hr * nw[j]); r[4 + j] = siluf_(z1[j]) * (hv[4 + j] * hr * nw[4 + j]); }
                        *(u32x4*)yp = pack8(r); asm volatile("" ::: "memory"); } }
        } else {
            const int col0 = (pn - 9) * 256 + wc * 32 + 8 * fq;
            float rs8[2][4];
#pragma unroll
            for (int ai = 0; ai < 2; ++ai)
#pragma unroll
                for (int m = 0; m < 4; ++m) rs8[ai][m] = rss[row0 + ai * 128 + m * 16];
            asm volatile("s_waitcnt vmcnt(0)" ::: "memory");
#pragma unroll
            for (int ai = 0; ai < 2; ++ai)
#pragma unroll
                for (int m = 0; m < 4; ++m) { const int row = row0 + ai * 128 + m * 16; const float rs = rs8[ai][m]; bf16_t* rowp = sg + (size_t)row * 3072 + col0;
#pragma unroll
                    for (int bj = 0; bj < 2; ++bj) { const f32x4 v0 = acc[ai][bj][m][0] * rs, v1 = acc[ai][bj][m][1] * rs; float r[8];
#pragma unroll
                        for (int j = 0; j < 4; ++j) { r[j] = sigmoidf_(v0[j]); r[4 + j] = sigmoidf_(v1[j]); }
                        *(u32x4*)(rowp + bj * 128) = pack8(r); } }
        }
    }
};
struct EpiG2 {
    static constexpr bool PERM = true, AFTER_DRAIN = false;
    const bf16_t* ycp; const bf16_t* scz; bf16_t* y2;
    __device__ __forceinline__ void operator()(const f32x4 (&acc)[2][2][4][2], const Unit& u, int wr, int wc, int fr, int fq) const {
        const int row0 = u.pm * 256 + wr * 64 + fr, col0 = u.pn * 256 + wc * 32 + 8 * fq;
#pragma unroll
        for (int ai = 0; ai < 2; ++ai)
#pragma unroll
            for (int m = 0; m < 4; ++m) { const int row = row0 + ai * 128 + m * 16;
#pragma unroll
                for (int bj = 0; bj < 2; ++bj) { const int col = col0 + bj * 128; float a[8], z[8], r[8];
                    unpack8(*(const u32x4*)(ycp + (size_t)row * 512 + col), a); unpack8(*(const u32x4*)(scz + (size_t)row * 512 + col), z);
                    const f32x4 v0 = acc[ai][bj][m][0], v1 = acc[ai][bj][m][1];
#pragma unroll
                    for (int j = 0; j < 4; ++j) { r[j] = a[j] * sigmoidf_(v0[j]) * z[j]; r[4 + j] = a[4 + j] * sigmoidf_(v1[j]) * z[4 + j]; }
                    *(u32x4*)(y2 + (size_t)row * 768 + col) = pack8(r); } asm volatile("" ::: "memory"); }
    }
};
struct EpiG3 {
    static constexpr bool PERM = true, AFTER_DRAIN = false;
    const bf16_t* sg; bf16_t* merged;
    __device__ __forceinline__ void operator()(const f32x4 (&acc)[2][2][4][2], const Unit& u, int wr, int wc, int fr, int fq) const {
        const int br = u.pm >> 6, pm = u.pm & 63, pn = u.pn & 3;
        const int row0 = pm * 256 + wr * 64 + fr, col0 = pn * 256 + wc * 32 + 8 * fq;
        u32x4 pk[2][4][2];
#pragma unroll
        for (int ai = 0; ai < 2; ++ai)
#pragma unroll
            for (int m = 0; m < 4; ++m)
#pragma unroll
                for (int bj = 0; bj < 2; ++bj) { const f32x4 v0 = acc[ai][bj][m][0], v1 = acc[ai][bj][m][1]; u32x4 w; w.x = cvt_pk_bf16(v0[0], v0[1]); w.y = cvt_pk_bf16(v0[2], v0[3]); w.z = cvt_pk_bf16(v1[0], v1[1]); w.w = cvt_pk_bf16(v1[2], v1[3]); pk[ai][m][bj] = w; }
#pragma unroll
        for (int ai = 0; ai < 2; ++ai) {
            u32x4 gq[4][2], pq[4][2];
#pragma unroll
            for (int m = 0; m < 4; ++m) { const int row = row0 + ai * 128 + m * 16;
#pragma unroll
                for (int bj = 0; bj < 2; ++bj) { gq[m][bj] = *(const u32x4*)(sg + (size_t)row * 3072 + br * 1024 + col0 + bj * 128); if (br != 0) pq[m][bj] = *(const u32x4*)(merged + (size_t)row * 1024 + col0 + bj * 128); } }
            asm volatile("s_waitcnt vmcnt(0)" ::: "memory");
#pragma unroll
            for (int m = 0; m < 4; ++m) { const int row = row0 + ai * 128 + m * 16;
#pragma unroll
                for (int bj = 0; bj < 2; ++bj) { u32x4 w; const u32x4 gv = gq[m][bj], av = pk[ai][m][bj], pvv = pq[m][bj];
#pragma unroll
                    for (int hq = 0; hq < 4; ++hq) { const unsigned gw = hq == 0 ? gv.x : hq == 1 ? gv.y : hq == 2 ? gv.z : gv.w, aw = hq == 0 ? av.x : hq == 1 ? av.y : hq == 2 ? av.z : av.w;
                        float r0 = __uint_as_float(gw << 16) * __uint_as_float(aw << 16), r1 = __uint_as_float(gw & 0xffff0000u) * __uint_as_float(aw & 0xffff0000u);
                        if (br != 0) { const unsigned pw = hq == 0 ? pvv.x : hq == 1 ? pvv.y : hq == 2 ? pvv.z : pvv.w; r0 += __uint_as_float(pw << 16); r1 += __uint_as_float(pw & 0xffff0000u); }
                        const unsigned o = cvt_pk_bf16(r0, r1); if (hq == 0) w.x = o; else if (hq == 1) w.y = o; else if (hq == 2) w.z = o; else w.w = o; }
                    *(u32x4*)(merged + (size_t)row * 1024 + col0 + bj * 128) = w; } }
            asm volatile("" ::: "memory"); }
    }
};
struct EpiG4 {
    static constexpr bool PERM = false, AFTER_DRAIN = false;
    const float* xprev; float* xnew; bf16_t* xw; const float* nwn; float* rss; int write_xw;
    __device__ __forceinline__ void operator()(const f32x4 (&acc)[2][2][4][2], const Unit& u, int wr, int wc, int fr, int fq) const {
        const int row0 = u.pm * 256 + wr * 64 + fr, col0 = u.pn * 256 + wc * 32 + 4 * fq;
        f32x4 nv[2][2];
#pragma unroll
        for (int bj = 0; bj < 2; ++bj)
#pragma unroll
            for (int n = 0; n < 2; ++n) nv[bj][n] = *(const f32x4*)(nwn + col0 + bj * 128 + n * 16);
#pragma unroll
        for (int ai = 0; ai < 2; ++ai)
#pragma unroll
            for (int mp = 0; mp < 2; ++mp) {
                f32x4 xr[2][2][2];
#pragma unroll
                for (int q = 0; q < 2; ++q) { const size_t off = (size_t)(row0 + ai * 128 + (2 * mp + q) * 16) * 1024 + col0;
#pragma unroll
                    for (int bj = 0; bj < 2; ++bj)
#pragma unroll
                        for (int n = 0; n < 2; ++n) xr[q][bj][n] = *(const f32x4*)(xprev + off + bj * 128 + n * 16); }
                asm volatile("s_waitcnt vmcnt(0)" ::: "memory");
#pragma unroll
                for (int q = 0; q < 2; ++q) { const int m = 2 * mp + q; const int row = row0 + ai * 128 + m * 16; const size_t off = (size_t)row * 1024 + col0; float ss = 0.f;
#pragma unroll
                    for (int bj = 0; bj < 2; ++bj)
#pragma unroll
                        for (int n = 0; n < 2; ++n) { const f32x4 xv = xr[q][bj][n] + acc[ai][bj][m][n];
                            *(f32x4*)(xnew + off + bj * 128 + n * 16) = xv; ss += (xv[0] * xv[0] + xv[1] * xv[1]) + (xv[2] * xv[2] + xv[3] * xv[3]);
                            if (write_xw) { const f32x4 t = xv * nv[bj][n]; u32x2 w; w.x = cvt_pk_bf16(t[0], t[1]); w.y = cvt_pk_bf16(t[2], t[3]); *(u32x2*)(xw + off + bj * 128 + n * 16) = w; } }
                    ss += __shfl_xor(ss, 16); ss += __shfl_xor(ss, 32);
                    if (fq == 0) rss[(size_t)row * 16 + u.pn * 4 + wc] = ss; }
                asm volatile("" ::: "memory"); }
    }
};
struct BranchOrder {
    int G, c;
    __device__ bool next(int i, Unit& u) const {
        const int j = i / 3, br = i - 3 * j; const long L = (long)j * G + c; if (L >= 256) return false;
        int wgid = (int)L; { const int q = 256 / 8, xcd = wgid % 8, off = wgid / 8; wgid = xcd * q + off; }
        const int nig = 8 * 4, gid = wgid / nig, fm = gid * 8; const int pm = fm + ((wgid % nig) % 8), pn = (wgid % nig) / 8;
        u.pm = br * 64 + pm; u.pn = br * 4 + pn; return true;
    }
    __device__ __forceinline__ void a_ready(const Unit&) const {}
    __device__ __forceinline__ void done(const Unit&) const {}
};

template <int KK> __device__ __forceinline__ f32x4 mma_tile(const LAS bf16_t* A, int lda, int r0, const LAS bf16_t* Bt, int ldb, int c0, f32x4 acc, int lane) {
    const int fr = lane & 15, fq = lane >> 4;
    const LAS bf16_t* ap = A + (r0 + fr) * lda + fq * 8; const LAS bf16_t* bp = Bt + (c0 + fr) * ldb + fq * 8;
#pragma unroll
    for (int k = 0; k < KK; k += 32) { const bf16x8 a = *(const LAS bf16x8*)(ap + k); const bf16x8 b = *(const LAS bf16x8*)(bp + k); acc = __builtin_amdgcn_mfma_f32_16x16x32_bf16(a, b, acc, 0, 0, 0); }
    return acc;
}
template <int CTRL, int RM> __device__ __forceinline__ float dpp_or(float oldv, float v) { return __int_as_float(__builtin_amdgcn_update_dpp(__float_as_int(oldv), __float_as_int(v), CTRL, RM, 0xF, false)); }
__device__ __forceinline__ float wave_scan_add(float v, int) {
    v += dpp_or<0x111, 0xF>(0.f, v); v += dpp_or<0x112, 0xF>(0.f, v); v += dpp_or<0x114, 0xF>(0.f, v); v += dpp_or<0x118, 0xF>(0.f, v);
    v += dpp_or<0x142, 0xA>(0.f, v); v += dpp_or<0x143, 0xC>(0.f, v); return v;
}
__device__ __forceinline__ float wave_scan_max(float v, int) {
    v = fmaxf(v, dpp_or<0x111, 0xF>(v, v)); v = fmaxf(v, dpp_or<0x112, 0xF>(v, v)); v = fmaxf(v, dpp_or<0x114, 0xF>(v, v)); v = fmaxf(v, dpp_or<0x118, 0xF>(v, v));
    v = fmaxf(v, dpp_or<0x142, 0xA>(v, v)); v = fmaxf(v, dpp_or<0x143, 0xC>(v, v)); return v;
}

template <int CTRL> __device__ __forceinline__ float dppf(float v) { return __int_as_float(__builtin_amdgcn_update_dpp(0, __float_as_int(v), CTRL, 0xF, 0xF, true)); }
__device__ __forceinline__ float rflf(float v) { return __int_as_float(__builtin_amdgcn_readfirstlane(__float_as_int(v))); }
__device__ __forceinline__ float quadsum(float v) { v += dppf<0xB1>(v); v += dppf<0x4E>(v); return v; }
__device__ __forceinline__ float rowsum16(float v) { v += dppf<0xB1>(v); v += dppf<0x4E>(v); v += dppf<0x141>(v); v += dppf<0x140>(v); return v; }
__device__ __forceinline__ float rowbcast4(float v, int r) { switch (r) { case 0: return dppf<0x150>(v); case 1: return dppf<0x154>(v); case 2: return dppf<0x158>(v); default: return dppf<0x15C>(v); } }
__device__ __forceinline__ int colmap(int type, int n) {
    if (type == 1) {
        if (n < 2304) return n;
        if (n < 3072) return 3848 + (n - 2304);
        if (n < 3840) return 4616 + (n - 3072);
        if (n < 4352) return 6168 + (n - 3840);
        if (n < 4864) return 6680 + (n - 4352);
        const int j = n - 4864; if (j < 4) return 3072 + j; if (j < 8) return 3076 + (j - 4); if (j < 24) return 5384 + (j - 8); return -1;
    }
    if (type == 2) {
        if (n < 1536) { const int t = n >> 8, hf = (n >> 7) & 1, x = n & 127; return (hf ? 3080 : 2304) + 128 * t + x; }
        if (n < 2304) return 5400 + (n - 1536);
        return 7192 + (n - 2304);
    }
    return n;
}
__device__ __forceinline__ void convert_job(LAS float* tl, const float* src, int lds_, int ks, bf16_t* dst, int kd, int nrows, int type, int G, int c) {
    int tid_l = threadIdx.x; asm volatile("" : "+v"(tid_l)); const int tid = tid_l; const int nkt = kd / 64, nnt = nrows / 64, ntiles = nkt * nnt;
    float pf[8];
#define CONV_LOAD(tt) do { const int kt_ = (tt) % nkt, nt_ = (tt) / nkt; const int k0_ = kt_ * 64, n0_ = nt_ * 64; const int sc_ = colmap(type, n0_ + (tid & 63)); \
        _Pragma("unroll") for (int i_ = 0; i_ < 8; ++i_) { const int kk_ = (tid >> 6) + 8 * i_; float v_ = 0.f; if (sc_ >= 0 && (k0_ + kk_) < ks) v_ = src[(size_t)(k0_ + kk_) * lds_ + sc_]; pf[i_] = v_; } } while (0)
    if (c < ntiles) CONV_LOAD(c);
    for (int t = c; t < ntiles; t += G) {
        const int kt = t % nkt, nt = t / nkt; const int k0 = kt * 64, n0 = nt * 64;
        asm volatile("s_waitcnt vmcnt(0)" ::: "memory");
        { const int nn = tid & 63;
#pragma unroll
          for (int i = 0; i < 8; ++i) { const int kk = (tid >> 6) + 8 * i; tl[nn * 65 + kk] = pf[i]; } }
        if (t + G < ntiles) CONV_LOAD(t + G);
        __syncthreads();
        { const int nn = tid >> 3, kseg = tid & 7; float f[8];
#pragma unroll
          for (int j = 0; j < 8; ++j) f[j] = tl[nn * 65 + kseg * 8 + j];
          *(u32x4*)(dst + (size_t)(n0 + nn) * kd + k0 + kseg * 8) = pack8(f); }
        __syncthreads();
    }
#undef CONV_LOAD
}
__device__ __forceinline__ void phase_convert(LAS unsigned char* lds, const Params p, int layer) {
    LAS float* tl = (LAS float*)lds; const int G = gridDim.x, c = blockIdx.x; unsigned char* ws = p.ws;
    const float* w_in = p.in[2] + (size_t)layer * 1024 * 10264;
    convert_job(tl, w_in, 10264, 1024, (bf16_t*)(ws + OFF_W1A), 1024, N1A, 1, G, c);
    convert_job(tl, w_in, 10264, 1024, (bf16_t*)(ws + OFF_W1B), 1024, N1B, 2, G, c);
    convert_job(tl, p.in[17] + (size_t)layer * 512 * 512, 512, 512, (bf16_t*)(ws + OFF_WGLU), 512, 512, 0, G, c);
    convert_job(tl, p.in[18] + (size_t)layer * 768 * 1024, 1024, 768, (bf16_t*)(ws + OFF_WBR), 768, 1024, 0, G, c);
    convert_job(tl, p.in[19] + (size_t)layer * 768 * 1024, 1024, 768, (bf16_t*)(ws + OFF_WBR) + (size_t)1024 * 768, 768, 1024, 0, G, c);
    convert_job(tl, p.in[20] + (size_t)layer * 512 * 1024, 1024, 512, (bf16_t*)(ws + OFF_WBR) + (size_t)2 * 1024 * 768, 768, 1024, 0, G, c);
    convert_job(tl, p.in[21] + (size_t)layer * 1024 * 1024, 1024, 1024, (bf16_t*)(ws + OFF_WOUT), 1024, 1024, 0, G, c);
    if (layer > 0) { const float* rss = (const float*)(ws + OFF_RSS); float* rstd = (float*)(ws + OFF_RSTD); int t2 = threadIdx.x; asm volatile("" : "+v"(t2)); for (int row = c * NTHR + t2; row < MTOK; row += G * NTHR) rstd[row] = row_rstd(rss, row); }
}
__device__ __forceinline__ void phase_prologue_x(const Params p) {
    int tid_l = threadIdx.x; asm volatile("" : "+v"(tid_l)); const int tid = tid_l, lane = tid & 63, wid = tid >> 6; const int G = gridDim.x; unsigned char* ws = p.ws;
    const float* x = p.in[0]; const float* nw = p.in[1]; bf16_t* xw = (bf16_t*)(ws + OFF_XW); float* rstd = (float*)(ws + OFF_RSTD);
    f32x4 nv[4];
#pragma unroll
    for (int i = 0; i < 4; ++i) nv[i] = *(const f32x4*)(nw + i * 256 + lane * 4);
    for (int row = blockIdx.x * 8 + wid; row < MTOK; row += G * 8) {
        float ss = 0.f;
#pragma unroll
        for (int i = 0; i < 4; ++i) { const f32x4 v = *(const f32x4*)(x + (size_t)row * 1024 + i * 256 + lane * 4); ss += (v[0] * v[0] + v[1] * v[1]) + (v[2] * v[2] + v[3] * v[3]);
            const f32x4 t = v * nv[i]; u32x2 w; w.x = cvt_pk_bf16(t[0], t[1]); w.y = cvt_pk_bf16(t[2], t[3]); *(u32x2*)(xw + (size_t)row * 1024 + i * 256 + lane * 4) = w; }
#pragma unroll
        for (int o = 32; o >= 1; o >>= 1) ss += __shfl_xor(ss, o);
        if (lane == 0) rstd[row] = rsqrtf(ss * (1.0f / 1024.0f) + 1e-6f);
    }
}

constexpr size_t OFF_QG = OFF_MERGED;
constexpr size_t OFF_SCO = OFF_MERGED + (size_t)MTOK * 768 * 2;
constexpr size_t OFF_KTG = OFF_SG + (size_t)MTOK * 2304 * 2;
constexpr size_t OFF_Y2 = OFF_Y + (size_t)2 * MTOK * 768 * 2;
constexpr size_t OFF_KTB = OFF_Y2;
constexpr size_t OFF_PGB = OFF_KTB + (size_t)1024 * 96 * 64 * 2;
constexpr size_t OFF_ELAST = OFF_PGB + (size_t)1024 * 64 * 64 * 2;
constexpr size_t OFF_GT = OFF_ELAST + (size_t)1024 * 96 * 4;
constexpr size_t OFF_CHS = OFF_GT + (size_t)1024 * 3 * 64 * 4;
static_assert(OFF_CHS + 1024 * 2 * 4 <= OFF_Y2 + (size_t)MTOK * 768 * 2, "Y[2] scratch overflow");

__device__ __forceinline__ void mlstm_pre(LAS unsigned char* lds, const Params p, int layer, int item) {
    int tid_l = threadIdx.x; asm volatile("" : "+v"(tid_l)); const int tid = tid_l, lane = tid & 63, wid = __builtin_amdgcn_readfirstlane(tid >> 6), fr = lane & 15, fq = lane >> 4;
    const int h = item & 3, ci = item >> 2, c = ci & 63, b = ci >> 6, row0 = ci * 64;
    unsigned char* ws = p.ws;
    const bf16_t* aqk = (const bf16_t*)(ws + OFF_SG); const float* small = (const float*)(ws + OFF_SMALL);
    bf16_t* qg = (bf16_t*)(ws + OFF_QG); bf16_t* sco = (bf16_t*)(ws + OFF_SCO) + (size_t)item * 4096; bf16_t* ktg = (bf16_t*)(ws + OFF_KTG) + (size_t)item * 192 * 64;
    float* gt = (float*)(ws + OFF_GT) + (size_t)item * 192; float* chs = (float*)(ws + OFF_CHS) + item * 2;
    const float* convw = p.in[3] + (size_t)layer * 4 * 1536; const float bi = p.in[4][layer * 8 + h], bfg = p.in[4][layer * 8 + 4 + h];
    LAS bf16_t* Qs = (LAS bf16_t*)lds; LAS bf16_t* Ks = Qs + 64 * 200;
    const float kscale = 0.07216878364870322f;
    if (wid == 0) {
        const float ip = small[(size_t)(row0 + lane) * 32 + h] + bi; const float fp = small[(size_t)(row0 + lane) * 32 + 4 + h] + bfg;
        const float bc = wave_scan_add(logsigmoidf_(fp), lane); const float g = ip - bc; const float cm = wave_scan_max(g, lane);
        gt[lane] = g; gt[64 + lane] = cm; gt[128 + lane] = bc;
        if (lane == 63) { chs[0] = bc; chs[1] = cm; }
    }
    u32x4 qws[3];
#pragma unroll
    for (int kt = 0; kt < 3; ++kt) { const int task = tid + NTHR * kt;
        const int t = task / 24, d8 = task - t * 24; const int ch = h * 192 + d8 * 8;
        float aq[8], ak[8];
#pragma unroll
        for (int j = 0; j < 8; ++j) { aq[j] = 0.f; ak[j] = 0.f; }
#pragma unroll
        for (int tap = 0; tap < 4; ++tap) { const int tt = c * 64 + t - 3 + tap;
            if (tt >= 0) { const bf16_t* rp = aqk + (size_t)(b * SEQ + tt) * 1536 + ch; float rq[8], rk[8]; unpack8(*(const u32x4*)rp, rq); unpack8(*(const u32x4*)(rp + 768), rk);
                const float* wq = convw + tap * 1536 + ch; const f32x4 q0 = *(const f32x4*)wq, q1 = *(const f32x4*)(wq + 4), k0 = *(const f32x4*)(wq + 768), k1 = *(const f32x4*)(wq + 772);
#pragma unroll
                for (int j = 0; j < 4; ++j) { aq[j] += q0[j] * rq[j]; aq[4 + j] += q1[j] * rq[4 + j]; ak[j] += k0[j] * rk[j]; ak[4 + j] += k1[j] * rk[4 + j]; } } }
#pragma unroll
        for (int j = 0; j < 8; ++j) { aq[j] = siluf_(aq[j]); ak[j] = siluf_(ak[j]) * kscale; }
        const u32x4 qw = pack8(aq);
        *(LAS u32x4*)(Qs + t * 200 + d8 * 8) = qw; *(LAS u32x4*)(Ks + t * 200 + d8 * 8) = pack8(ak);
        qws[kt] = qw;
    }
    asm volatile("s_waitcnt vmcnt(0)" ::: "memory");
#pragma unroll
    for (int kt = 0; kt < 3; ++kt) { const int task = tid + NTHR * kt; const int t = task / 24, d8 = task - t * 24; *(u32x4*)(qg + (size_t)(row0 + t) * 768 + h * 192 + d8 * 8) = qws[kt]; }
    if (c < VGC) { const bf16_t* y0 = (const bf16_t*)(ws + OFF_Y); bf16_t* vg = (bf16_t*)(ws + OFF_VG) + (size_t)((b * VGC + c) * 4 + h) * 12288;
#pragma unroll
        for (int k = 0; k < 3; ++k) { const int i = tid + NTHR * k; const int t = i / 24, d8 = i - t * 24; *(u32x4*)(vg + t * 192 + d8 * 8) = *(const u32x4*)(y0 + (size_t)(row0 + t) * 768 + h * 192 + d8 * 8); } }
    __syncthreads();
    { const int tr = wid >> 1;
#pragma unroll
      for (int q = 0; q < 2; ++q) { const int tc = (wid & 1) * 2 + q; f32x4 a = (f32x4){0.f, 0.f, 0.f, 0.f};
          if (tc <= tr) a = mma_tile<192>(Qs, 200, 16 * tr, Ks, 200, 16 * tc, a, lane);
          const int s = 16 * tc + fr;
#pragma unroll
          for (int r = 0; r < 4; ++r) { const int t = 16 * tr + 4 * fq + r; sco[t * 64 + s] = f2bf((s <= t) ? a[r] : 0.f); } } }
    for (int task = tid; task < 192 * 8; task += NTHR) { const int s8 = task / 192, d = task - s8 * 192; float f[8];
#pragma unroll
        for (int j = 0; j < 8; ++j) f[j] = bf2f(Ks[(s8 * 8 + j) * 200 + d]);
        *(u32x4*)(ktg + d * 64 + s8 * 8) = pack8(f); }
    __syncthreads();
}

__device__ __forceinline__ void gla_pre(LAS unsigned char* lds, const Params p, int layer, int item) {
    int tid_l = threadIdx.x; asm volatile("" : "+v"(tid_l)); const int tid = tid_l, lane = tid & 63, wid = __builtin_amdgcn_readfirstlane(tid >> 6), fr = lane & 15, fq = lane >> 4;
    const int h = item & 3, ci = item >> 2, row0 = ci * 64;
    unsigned char* ws = p.ws;
    bf16_t* bqk = (bf16_t*)(ws + OFF_SG) + (size_t)MTOK * 1536; const float* small = (const float*)(ws + OFF_SMALL);
    bf16_t* ktb = (bf16_t*)(ws + OFF_KTB) + (size_t)item * 96 * 64; bf16_t* pgb = (bf16_t*)(ws + OFF_PGB) + (size_t)item * 4096; float* elast = (float*)(ws + OFF_ELAST) + item * 96;
    const float* walpha = p.in[6] + (size_t)layer * 16 * 384; const float* balpha = p.in[7] + (size_t)layer * 384;
    LAS bf16_t* Qs = (LAS bf16_t*)lds; LAS bf16_t* Ks = Qs + 64 * 104; LAS float* Bc = (LAS float*)(Ks + 64 * 104); LAS float* BAs = Bc + 64 * 97;
    const int gd = tid % 96, gtq = tid / 96; float wal[16]; float bal = 0.f;
    if (tid < 384) {
#pragma unroll
        for (int r = 0; r < 16; ++r) wal[r] = walpha[r * 384 + h * 96 + gd];
        bal = balpha[h * 96 + gd]; }
    const float qscale = 0.10206207261596575f;
    u32x4 rq[2], rk[2];
#pragma unroll
    for (int k = 0; k < 2; ++k) { const int task = tid + NTHR * k; if (task < 768) { const int t = task / 12, d8 = task - t * 12; const bf16_t* rp = bqk + (size_t)(row0 + t) * 768 + h * 96 + d8 * 8; rq[k] = *(const u32x4*)rp; rk[k] = *(const u32x4*)(rp + 384); } }
    for (int i = tid; i < 64 * 4; i += NTHR) { const int t = i >> 2, q = i & 3; *(LAS f32x4*)(BAs + t * 16 + q * 4) = *(const f32x4*)(small + (size_t)(row0 + t) * 32 + 8 + q * 4); }
    __syncthreads();
    if (tid < 384) {
#pragma unroll 4
        for (int i = 0; i < 16; ++i) { const int t = gtq * 16 + i; float z = bal;
#pragma unroll
            for (int r = 0; r < 16; ++r) z += BAs[t * 16 + r] * wal[r];
            Bc[t * 97 + gd] = logsigmoidf_(z) * (1.0f / 16.0f); } }
    __syncthreads();
    for (int i = 0; i < 12; ++i) { const int d = wid * 12 + i; const float v = wave_scan_add(Bc[lane * 97 + d], lane); Bc[lane * 97 + d] = v; }
    __syncthreads();
    asm volatile("s_waitcnt vmcnt(0)" ::: "memory");
#pragma unroll
    for (int kk = 0; kk < 2; ++kk) { const int task = tid + NTHR * kk; if (task >= 768) continue;
        const int t = task / 12, d8 = task - t * 12; bf16_t* rp = bqk + (size_t)(row0 + t) * 768 + h * 96 + d8 * 8; float q[8], k[8];
        unpack8(rq[kk], q); unpack8(rk[kk], k);
#pragma unroll
        for (int j = 0; j < 8; ++j) { const float bc = Bc[t * 97 + d8 * 8 + j]; q[j] = q[j] * qscale * __expf(bc); k[j] = k[j] * __expf(-bc); }
        const u32x4 qw = pack8(q);
        *(LAS u32x4*)(Qs + t * 104 + d8 * 8) = qw; *(LAS u32x4*)(Ks + t * 104 + d8 * 8) = pack8(k);
        *(u32x4*)rp = qw;
    }
    if (tid < 96) elast[tid] = __expf(Bc[63 * 97 + tid]);
    __syncthreads();
    { const int tr = wid >> 1;
#pragma unroll
      for (int q = 0; q < 2; ++q) { const int tc = (wid & 1) * 2 + q; f32x4 a = (f32x4){0.f, 0.f, 0.f, 0.f};
          if (tc <= tr) a = mma_tile<96>(Qs, 104, 16 * tr, Ks, 104, 16 * tc, a, lane);
          const int s = 16 * tc + fr;
#pragma unroll
          for (int r = 0; r < 4; ++r) { const int t = 16 * tr + 4 * fq + r; pgb[t * 64 + s] = f2bf((s <= t) ? a[r] : 0.f); } } }
    for (int task = tid; task < 96 * 8; task += NTHR) { const int s8 = task / 96, d = task - s8 * 96; float f[8];
#pragma unroll
        for (int j = 0; j < 8; ++j) f[j] = bf2f(Ks[(s8 * 8 + j) * 104 + d]);
        *(u32x4*)(ktb + d * 64 + s8 * 8) = pack8(f); }
    __syncthreads();
}

__device__ __forceinline__ void mlstm_item(LAS unsigned char* lds, const Params p, int layer, int item) {
    int tid_l = threadIdx.x; asm volatile("" : "+v"(tid_l)); const int tid = tid_l, lane = tid & 63, wid = __builtin_amdgcn_readfirstlane(tid >> 6), fr = lane & 15, fq = lane >> 4;
    const int seqhalf = item % 3, half = (item / 3) & 1, bh = item / 6, h = bh & 3, b = bh >> 2, e_base = half * 96;
    const int cout0 = seqhalf == 0 ? 0 : (seqhalf == 1 ? 21 : 42), cend = seqhalf == 0 ? 21 : (seqhalf == 1 ? 42 : 64);
    unsigned char* ws = p.ws;
    bf16_t* y0 = (bf16_t*)(ws + OFF_Y); float* sta = (float*)(ws + OFF_STA);
    const bf16_t* qg = (const bf16_t*)(ws + OFF_QG); const bf16_t* sco = (const bf16_t*)(ws + OFF_SCO); const bf16_t* ktg = (const bf16_t*)(ws + OFF_KTG);
    const float* gt = (const float*)(ws + OFF_GT); const float* chs = (const float*)(ws + OFF_CHS); const bf16_t* vg = (const bf16_t*)(ws + OFF_VG);
    LAS bf16_t* Qs = (LAS bf16_t*)lds; LAS bf16_t* KTw = Qs + 64 * 200; LAS bf16_t* VTs = KTw + 192 * 72; LAS bf16_t* Ss = VTs + 96 * 72; LAS bf16_t* CTs = Ss + 64 * 72;
    LAS float* fv = (LAS float*)(CTs + 96 * 200);
    LAS float* cmS = fv; LAS float* bcS = fv + 64; LAS float* dinvS = fv + 128; LAS float* wintS = fv + 192; LAS float* nv0 = fv + 256; LAS float* nv1 = nv0 + 192; LAS float* stS = nv1 + 192;
    for (int i = tid; i < 384; i += NTHR) nv0[i] = 0.f;
    f32x4 cacc[12];
#pragma unroll
    for (int i = 0; i < 12; ++i) cacc[i] = (f32x4){0.f, 0.f, 0.f, 0.f};
    float mstate = 0.f;
    u32x4 pq[3], pk[3], ps; u32x2 pv[3]; float pg8v[8], pcm, pcm2 = 0.f, pbc2 = 0.f; float pbend, pgmax;
    const int st_t = tid >> 3, st_s8 = tid & 7;
#define MLSTM_PREFETCH(cc) do { const int ch_ = ((b * 64 + (cc)) * 4 + h); const int r0_ = b * SEQ + (cc) * 64; \
        const bool vc_ = (cc) < cout0; const bf16_t* vb_ = vc_ ? vg + (size_t)((b * VGC + (cc)) * 4 + h) * 12288 + e_base : y0 + (size_t)r0_ * 768 + h * 192 + e_base; const int vp_ = vc_ ? 192 : 768; \
        _Pragma("unroll") for (int k_ = 0; k_ < 3; ++k_) { const int i_ = tid + NTHR * k_; const int t_ = i_ / 24, d8_ = i_ - t_ * 24; if ((cc) >= cout0) pq[k_] = *(const u32x4*)(qg + (size_t)(r0_ + t_) * 768 + h * 192 + d8_ * 8); \
            pk[k_] = *(const u32x4*)(ktg + (size_t)ch_ * 12288 + (size_t)i_ * 8); \
            pv[k_] = *(const u32x2*)(vb_ + (size_t)t_ * vp_ + d8_ * 4); } \
        if ((cc) >= cout0) ps = *(const u32x4*)(sco + (size_t)ch_ * 4096 + st_t * 64 + st_s8 * 8); \
        { const f32x4 ga_ = *(const f32x4*)(gt + (size_t)ch_ * 192 + st_s8 * 8), gb_ = *(const f32x4*)(gt + (size_t)ch_ * 192 + st_s8 * 8 + 4); \
          pg8v[0] = ga_[0]; pg8v[1] = ga_[1]; pg8v[2] = ga_[2]; pg8v[3] = ga_[3]; pg8v[4] = gb_[0]; pg8v[5] = gb_[1]; pg8v[6] = gb_[2]; pg8v[7] = gb_[3]; } \
        pcm = gt[(size_t)ch_ * 192 + 64 + st_t]; \
        if (tid < 64) { pcm2 = gt[(size_t)ch_ * 192 + 64 + tid]; pbc2 = gt[(size_t)ch_ * 192 + 128 + tid]; } \
        pbend = chs[ch_ * 2]; pgmax = chs[ch_ * 2 + 1]; } while (0)
    MLSTM_PREFETCH(0);
    __syncthreads();
    for (int c = 0; c < cend; ++c) {
        const int row0 = b * SEQ + c * 64; const bool do_out = (c >= cout0);
        LAS float* ncur = (c & 1) ? nv1 : nv0; LAS float* nnext = (c & 1) ? nv0 : nv1;
        asm volatile("s_waitcnt vmcnt(0)" ::: "memory");
        const float mx = rflf(fmaxf(mstate, pgmax)); const float mnew = rflf(pbend + mx); const float wprev = rflf(__expf(mstate - mx)); const float mcur = mstate;
        { float wk8[8];
#pragma unroll
          for (int j = 0; j < 8; ++j) wk8[j] = __expf(pg8v[j] - mx);
#pragma unroll
          for (int k = 0; k < 3; ++k) { const int i = tid + NTHR * k; const int t = i / 24, d8 = i - t * 24; if (do_out) *(LAS u32x4*)(Qs + t * 200 + d8 * 8) = pq[k];
              const int d = i >> 3; float f[8]; unpack8(pk[k], f);
#pragma unroll
              for (int j = 0; j < 8; ++j) f[j] *= wk8[j];
              *(LAS u32x4*)(KTw + d * 72 + st_s8 * 8) = pack8(f);
              const int ve = d8 * 4; VTs[(ve + 0) * 72 + t] = (bf16_t)(pv[k].x & 0xffffu); VTs[(ve + 1) * 72 + t] = (bf16_t)(pv[k].x >> 16); VTs[(ve + 2) * 72 + t] = (bf16_t)(pv[k].y & 0xffffu); VTs[(ve + 3) * 72 + t] = (bf16_t)(pv[k].y >> 16); }
          if (do_out) { float f[8]; unpack8(ps, f); const float mm = fmaxf(mcur, pcm);
#pragma unroll
            for (int j = 0; j < 8; ++j) f[j] = (st_s8 * 8 + j <= st_t) ? f[j] * __expf(pg8v[j] - mm) : 0.f;
            *(LAS u32x4*)(Ss + st_t * 72 + st_s8 * 8) = pack8(f); } }
        if (tid < 64) { cmS[tid] = pcm2; bcS[tid] = pbc2; }
        if (wid < 6 && do_out) {
#pragma unroll
            for (int dc = 0; dc < 12; ++dc) { u32x2 w; w.x = cvt_pk_bf16(cacc[dc][0], cacc[dc][1]); w.y = cvt_pk_bf16(cacc[dc][2], cacc[dc][3]); *(LAS u32x2*)(CTs + (16 * wid + fr) * 200 + 16 * dc + 4 * fq) = w; } }
        if (c + 1 < cend) MLSTM_PREFETCH(c + 1);
        __syncthreads();
        f32x4 onum[4];
        if (wid < 6) {
            const LAS bf16_t* vtp = VTs + (16 * wid + fr) * 72 + 8 * fq; const bf16x8 vt0 = *(const LAS bf16x8*)vtp, vt1 = *(const LAS bf16x8*)(vtp + 32);
#pragma unroll
            for (int dc = 0; dc < 12; ++dc) { const LAS bf16_t* kp = KTw + (16 * dc + fr) * 72 + 8 * fq; const bf16x8 a0 = *(const LAS bf16x8*)kp, a1 = *(const LAS bf16x8*)(kp + 32);
                cacc[dc] = cacc[dc] * wprev; cacc[dc] = __builtin_amdgcn_mfma_f32_16x16x32_bf16(a0, vt0, cacc[dc], 0, 0, 0); cacc[dc] = __builtin_amdgcn_mfma_f32_16x16x32_bf16(a1, vt1, cacc[dc], 0, 0, 0);
                if ((dc & 3) == 3) asm volatile("" ::: "memory"); }
            const LAS bf16_t* ctp = CTs + (16 * wid + fr) * 200 + 8 * fq;
            if (do_out) {
#pragma unroll
            for (int tr = 0; tr < 4; ++tr) { f32x4 a = (f32x4){0.f, 0.f, 0.f, 0.f}; const LAS bf16_t* qp = Qs + (16 * tr + fr) * 200 + 8 * fq;
#pragma unroll
                for (int k = 0; k < 6; ++k) a = __builtin_amdgcn_mfma_f32_16x16x32_bf16(*(const LAS bf16x8*)(qp + 32 * k), *(const LAS bf16x8*)(ctp + 32 * k), a, 0, 0, 0);
#pragma unroll
                for (int r = 0; r < 4; ++r) { const float cmv = cmS[16 * tr + 4 * fq + r]; a[r] *= __expf(mcur - fmaxf(mcur, cmv)); }
                const LAS bf16_t* sp = Ss + (16 * tr + fr) * 72 + 8 * fq;
                a = __builtin_amdgcn_mfma_f32_16x16x32_bf16(*(const LAS bf16x8*)sp, vt0, a, 0, 0, 0); a = __builtin_amdgcn_mfma_f32_16x16x32_bf16(*(const LAS bf16x8*)(sp + 32), vt1, a, 0, 0, 0);
                onum[tr] = a; asm volatile("" ::: "memory"); } }
        } else {
            const int ht = tid - 384, row = ht >> 1, hf = ht & 1; float rs = 0.f, qn = 0.f;
            if (do_out) {
#pragma unroll
            for (int i = 0; i < 4; ++i) { float f[8]; unpack8(*(const LAS u32x4*)(Ss + row * 72 + hf * 32 + i * 8), f); rs += ((f[0] + f[1]) + (f[2] + f[3])) + ((f[4] + f[5]) + (f[6] + f[7])); }
#pragma unroll
            for (int i = 0; i < 12; ++i) { float f[8]; unpack8(*(const LAS u32x4*)(Qs + row * 200 + hf * 96 + i * 8), f);
#pragma unroll
                for (int j = 0; j < 8; ++j) qn += f[j] * ncur[hf * 96 + i * 8 + j]; }
            rs += dppf<0xB1>(rs); qn += dppf<0xB1>(qn);
            const float mm = fmaxf(mcur, cmS[row]); const float wint = __expf(mcur - mm); const float emt = __expf(-(bcS[row] + mm));
            const float den = rs + wint * qn; const float dinv = 1.0f / fmaxf(fabsf(den), emt);
            if (hf == 0) { dinvS[row] = dinv; wintS[row] = wint; } }
#pragma unroll
            for (int rep = 0; rep < 2; ++rep) { const int d = ht + 128 * rep; if (d < 192) { float s = 0.f;
#pragma unroll
                for (int i = 0; i < 8; ++i) { float f[8]; unpack8(*(const LAS u32x4*)(KTw + d * 72 + i * 8), f); s += ((f[0] + f[1]) + (f[2] + f[3])) + ((f[4] + f[5]) + (f[6] + f[7])); }
                nnext[d] = wprev * ncur[d] + s; } }
            if (c > cout0 && ht < 64) { float s1 = 0.f, s2 = 0.f;
#pragma unroll
                for (int w = 0; w < 6; ++w) { s1 += stS[(w * 64 + ht) * 2]; s2 += stS[(w * 64 + ht) * 2 + 1]; }
                *(f32x2v*)(sta + (((size_t)(row0 - 64 + ht) * 4 + h) * NSTA + half) * 2) = (f32x2v){s1, s2}; }
        }
        mstate = mnew;
        __syncthreads();
        if (wid < 6 && do_out) {
#pragma unroll
            for (int tr = 0; tr < 4; ++tr) { float s1[4], s2[4];
#pragma unroll
                for (int r = 0; r < 4; ++r) { const int t = 16 * tr + 4 * fq + r; const float o = onum[tr][r] * dinvS[t];
                    y0[(size_t)(row0 + t) * 768 + h * 192 + e_base + 16 * wid + fr] = f2bf(o);
                    s1[r] = rowsum16(o); s2[r] = rowsum16(o * o); }
                if (fr == 0) {
#pragma unroll
                    for (int r = 0; r < 4; ++r) { const int t = 16 * tr + 4 * fq + r; *(LAS f32x2v*)(stS + (wid * 64 + t) * 2) = (f32x2v){s1[r], s2[r]}; } }
                asm volatile("" ::: "memory"); }
        }
    }
    __syncthreads();
    if (tid < 64) { const int row0 = b * SEQ + (cend - 1) * 64; float s1 = 0.f, s2 = 0.f;
#pragma unroll
        for (int w = 0; w < 6; ++w) { s1 += stS[(w * 64 + tid) * 2]; s2 += stS[(w * 64 + tid) * 2 + 1]; }
        *(f32x2v*)(sta + (((size_t)(row0 + tid) * 4 + h) * NSTA + half) * 2) = (f32x2v){s1, s2}; }
    __syncthreads();
#undef MLSTM_PREFETCH
}

__device__ __forceinline__ void gla_item(LAS unsigned char* lds, const Params p, int layer, int item) {
    int tid_l = threadIdx.x; asm volatile("" : "+v"(tid_l)); const int tid = tid_l, lane = tid & 63, wid = __builtin_amdgcn_readfirstlane(tid >> 6), fr = lane & 15, fq = lane >> 4;
    const int es = item % 6, bh = item / 6, h = bh & 3, b = bh >> 2, e0 = es * 32;
    unsigned char* ws = p.ws;
    const bf16_t* bqk = (const bf16_t*)(ws + OFF_SG) + (size_t)MTOK * 1536; bf16_t* y1 = (bf16_t*)(ws + OFF_Y) + (size_t)MTOK * 768; float* stb = (float*)(ws + OFF_STB);
    const bf16_t* ktb = (const bf16_t*)(ws + OFF_KTB); const bf16_t* pgb = (const bf16_t*)(ws + OFF_PGB); const float* elast = (const float*)(ws + OFF_ELAST);
    LAS bf16_t* Qs = (LAS bf16_t*)lds; LAS bf16_t* KTs = Qs + 64 * 104; LAS bf16_t* VTs = KTs + 96 * 72; LAS bf16_t* Ss = VTs + 32 * 72; LAS bf16_t* STs = Ss + 64 * 72;
    LAS float* elS = (LAS float*)(STs + 32 * 104); LAS float* stx = elS + 96;
    f32x4 sacc[2]; sacc[0] = (f32x4){0.f, 0.f, 0.f, 0.f}; sacc[1] = (f32x4){0.f, 0.f, 0.f, 0.f};
    float st2[4];
    u32x4 pq[2], pk[2], ps; u32x2 pv; float pel = 0.f;
    const int st_t = tid >> 3, st_s8 = tid & 7, vs = tid >> 3, ve = (tid & 7) * 4;
#define GLA_PREFETCH(cc) do { const int ch_ = ((b * 64 + (cc)) * 4 + h); const int r0_ = b * SEQ + (cc) * 64; \
        _Pragma("unroll") for (int k_ = 0; k_ < 2; ++k_) { const int i_ = tid + NTHR * k_; if (i_ < 768) { const int t_ = i_ / 12, d8_ = i_ - t_ * 12; pq[k_] = *(const u32x4*)(bqk + (size_t)(r0_ + t_) * 768 + h * 96 + d8_ * 8); \
            pk[k_] = *(const u32x4*)(ktb + (size_t)ch_ * 6144 + (size_t)i_ * 8); } } \
        ps = *(const u32x4*)(pgb + (size_t)ch_ * 4096 + st_t * 64 + st_s8 * 8); \
        if (tid < 96) pel = elast[ch_ * 96 + tid]; \
        pv = *(const u32x2*)(y1 + (size_t)(r0_ + vs) * 768 + h * 192 + e0 + ve); } while (0)
    GLA_PREFETCH(0);
    __syncthreads();
    for (int c = 0; c < 64; ++c) {
        const int row0 = b * SEQ + c * 64;
        asm volatile("s_waitcnt vmcnt(0)" ::: "memory");
#pragma unroll
        for (int k = 0; k < 2; ++k) { const int i = tid + NTHR * k; if (i < 768) { const int t = i / 12, d8 = i - t * 12; *(LAS u32x4*)(Qs + t * 104 + d8 * 8) = pq[k];
            const int d = i >> 3, s8 = i & 7; *(LAS u32x4*)(KTs + d * 72 + s8 * 8) = pk[k]; } }
        *(LAS u32x4*)(Ss + st_t * 72 + st_s8 * 8) = ps;
        VTs[(ve + 0) * 72 + vs] = (bf16_t)(pv.x & 0xffffu); VTs[(ve + 1) * 72 + vs] = (bf16_t)(pv.x >> 16); VTs[(ve + 2) * 72 + vs] = (bf16_t)(pv.y & 0xffffu); VTs[(ve + 3) * 72 + vs] = (bf16_t)(pv.y >> 16);
        if (tid < 96) elS[tid] = pel;
        if (wid < 6) {
#pragma unroll
            for (int er = 0; er < 2; ++er)
#pragma unroll
                for (int r = 0; r < 4; ++r) STs[(16 * er + 4 * fq + r) * 104 + 16 * wid + fr] = f2bf(sacc[er][r]); }
        if (c > 0 && (wid & 1) == 0 && fr == 0) {
#pragma unroll
            for (int r = 0; r < 4; ++r) { const int tt = 16 * (wid >> 1) + 4 * fq + r; stb[((size_t)(row0 - 64 + tt) * 4 + h) * NSTAT + es] = st2[r] + stx[tt]; } }
        if (c + 1 < 64) GLA_PREFETCH(c + 1);
        __syncthreads();
        { const int tr = wid >> 1, ec = wid & 1; f32x4 o = (f32x4){0.f, 0.f, 0.f, 0.f};
          o = mma_tile<64>(Ss, 72, 16 * tr, VTs, 72, 16 * ec, o, lane);
          o = mma_tile<96>(Qs, 104, 16 * tr, STs, 104, 16 * ec, o, lane);
#pragma unroll
          for (int r = 0; r < 4; ++r) { const int tt = 16 * tr + 4 * fq + r; y1[(size_t)(row0 + tt) * 768 + h * 192 + e0 + 16 * ec + fr] = f2bf(o[r]);
              const float s2 = rowsum16(o[r] * o[r]);
              if (fr == 0) { if (ec) stx[tt] = s2; else st2[r] = s2; } } }
        if (wid < 6) { const float dec = elS[16 * wid + fr];
#pragma unroll
            for (int er = 0; er < 2; ++er) { sacc[er] = mma_tile<64>(VTs, 72, 16 * er, KTs, 72, 16 * wid, sacc[er], lane); sacc[er] = sacc[er] * dec; } }
        __syncthreads();
    }
    if ((wid & 1) == 0 && fr == 0) { const int row0 = b * SEQ + 63 * 64;
#pragma unroll
        for (int r = 0; r < 4; ++r) { const int tt = 16 * (wid >> 1) + 4 * fq + r; stb[((size_t)(row0 + tt) * 4 + h) * NSTAT + es] = st2[r] + stx[tt]; } }
    __syncthreads();
#undef GLA_PREFETCH
}


__device__ __forceinline__ void cmul(float ar, float ai, float br, float bi, float& cr, float& ci) { cr = ar * br - ai * bi; ci = ar * bi + ai * br; }
__device__ __forceinline__ void s5_item(LAS unsigned char* lds, const Params p, int layer, int item) {
    int tid_l = threadIdx.x; asm volatile("" : "+v"(tid_l)); const int tid = tid_l, lane = tid & 63, wid = __builtin_amdgcn_readfirstlane(tid >> 6), fr = lane & 15, fq = lane >> 4;
    const int g = item & 31, b = item >> 5; unsigned char* ws = p.ws;
    bf16_t* cu = (bf16_t*)(ws + OFF_CU);
    const float* lam_re = p.in[9] + (size_t)layer * 2048 + g * 64; const float* lam_im = p.in[10] + (size_t)layer * 2048 + g * 64; const float ldt = p.in[11][layer * 32 + g];
    const float* Bre = p.in[12] + ((size_t)layer * 32 + g) * 1024; const float* Bim = p.in[13] + ((size_t)layer * 32 + g) * 1024;
    const float* Cre = p.in[14] + ((size_t)layer * 32 + g) * 1024; const float* Cim = p.in[15] + ((size_t)layer * 32 + g) * 1024;
    const float dsk = p.in[16][layer * 512 + g * 16 + fr];
    LAS float* BU = (LAS float*)(lds + wid * 12288);
    LAS bf16_t* Xs = (LAS bf16_t*)(lds + wid * 12288 + 8192);
    LAS float* Es = (LAS float*)(lds + 8 * 12288);
    const float dt = __expf(ldt);
    float are, aim;
    { const float lr = fminf(lam_re[lane], -1e-4f), li = lam_im[lane]; const float mag = __expf(lr * dt); are = mag * cosf(li * dt); aim = mag * sinf(li * dt); }
    bf16x8 bbop[8];
#pragma unroll
    for (int ct = 0; ct < 8; ++ct) { const int pp = 16 * ct + fr, ps = pp >> 1, cc = pp & 1; float f[8];
        const float lr = fminf(lam_re[ps], -1e-4f), li = lam_im[ps]; const float mag = __expf(lr * dt); const float abr = mag * cosf(li * dt), abi = mag * sinf(li * dt);
        const float nr = abr - 1.0f, den = lr * lr + li * li; const float cre = (nr * lr + abi * li) / den, cim = (abi * lr - nr * li) / den;
#pragma unroll
        for (int j = 0; j < 8; ++j) { float v = 0.f; if (fq < 2) { const float br = Bre[ps * 16 + 8 * fq + j], bi = Bim[ps * 16 + 8 * fq + j]; v = cc ? (cre * bi + cim * br) : (cre * br - cim * bi); } f[j] = v; }
        const u32x4 w = pack8(f); bbop[ct] = *(const bf16x8*)&w; }
    bf16x8 cmop[4];
#pragma unroll
    for (int ks = 0; ks < 4; ++ks) { float f[8];
#pragma unroll
        for (int j = 0; j < 8; ++j) { const int pp = 32 * ks + 8 * fq + j, ps = pp >> 1; f[j] = (pp & 1) ? -Cim[fr * 64 + ps] : Cre[fr * 64 + ps]; }
        const u32x4 w = pack8(f); cmop[ks] = *(const bf16x8*)&w; }
    const int seg0 = b * SEQ + wid * 512;
    float xr = 0.f, xi = 0.f;
    for (int pass = 0; pass < 2; ++pass) {
        u32x4 aw_n = (u32x4){0u, 0u, 0u, 0u}; bf16_t uv_n[4] = {0, 0, 0, 0};
        if (fq < 2) aw_n = *(const u32x4*)(cu + (size_t)(seg0 + fr) * 512 + g * 16 + 8 * fq);
        if (pass) {
#pragma unroll
            for (int r = 0; r < 4; ++r) uv_n[r] = cu[(size_t)(seg0 + 4 * fq + r) * 512 + g * 16 + fr]; }
        float of[16];
        for (int tile4 = 0; tile4 < 8; ++tile4) {
#pragma unroll
        for (int tq = 0; tq < 4; ++tq) { const int tile = tile4 * 4 + tq;
            const int r0 = seg0 + tile * 16;
            asm volatile("s_waitcnt vmcnt(0)" ::: "memory");
            const u32x4 aw = aw_n; const bf16x8 aop = *(const bf16x8*)&aw; bf16_t uvc[4];
#pragma unroll
            for (int r = 0; r < 4; ++r) uvc[r] = uv_n[r];
            if (tile + 1 < 32) { if (fq < 2) aw_n = *(const u32x4*)(cu + (size_t)(r0 + 16 + fr) * 512 + g * 16 + 8 * fq);
                if (pass) {
#pragma unroll
                    for (int r = 0; r < 4; ++r) uv_n[r] = cu[(size_t)(r0 + 16 + 4 * fq + r) * 512 + g * 16 + fr]; } }
#pragma unroll
            for (int ct = 0; ct < 8; ++ct) { f32x4 a = (f32x4){0.f, 0.f, 0.f, 0.f}; a = __builtin_amdgcn_mfma_f32_16x16x32_bf16(aop, bbop[ct], a, 0, 0, 0);
#pragma unroll
                for (int r = 0; r < 4; ++r) BU[(4 * fq + r) * 128 + 16 * ct + fr] = a[r]; }
#pragma unroll
            for (int t = 0; t < 16; ++t) { const f32x2v bu = *(const LAS f32x2v*)(BU + t * 128 + 2 * lane); const float nr = are * xr - aim * xi + bu.x, ni = are * xi + aim * xr + bu.y; xr = nr; xi = ni;
                if (pass) *(LAS unsigned*)(Xs + t * 128 + 2 * lane) = cvt_pk_bf16(xr, xi); }
            if (pass) {
                f32x4 y = (f32x4){0.f, 0.f, 0.f, 0.f};
#pragma unroll
                for (int ks = 0; ks < 4; ++ks) { const bf16x8 xa = *(const LAS bf16x8*)(Xs + fr * 128 + 32 * ks + 8 * fq); y = __builtin_amdgcn_mfma_f32_16x16x32_bf16(xa, cmop[ks], y, 0, 0, 0); }
#pragma unroll
                for (int r = 0; r < 4; ++r) { const float uv = bf2f(uvc[r]); of[tq * 4 + r] = geluf_(y[r] + dsk * uv); }
            }
        }
        if (pass) {
#pragma unroll
            for (int tq = 0; tq < 4; ++tq)
#pragma unroll
                for (int r = 0; r < 4; ++r) cu[(size_t)(seg0 + (tile4 * 4 + tq) * 16 + 4 * fq + r) * 512 + g * 16 + fr] = f2bf(of[tq * 4 + r]); }
        }
        if (pass == 0) {
            Es[(wid * 64 + lane) * 2] = xr; Es[(wid * 64 + lane) * 2 + 1] = xi;
            __syncthreads();
            float pr = are, pi = aim;
#pragma unroll
            for (int i = 0; i < 9; ++i) { float tr, ti; cmul(pr, pi, pr, pi, tr, ti); pr = tr; pi = ti; }
            xr = 0.f; xi = 0.f;
            for (int w = 0; w < wid; ++w) { float tr, ti; cmul(pr, pi, xr, xi, tr, ti); xr = tr + Es[(w * 64 + lane) * 2]; xi = ti + Es[(w * 64 + lane) * 2 + 1]; }
        }
    }
    __syncthreads();
}

#define XB_TMO      128
#define XB_XCNT(j)  (256  + 64 * (j))
#define XB_XSUB(j)  (1280 + 64 * (j))
#define XB_XGEN(j)  (2304 + 64 * (j))
#define XB_TOP      3328
#define XB_TOPGEN   3392
#define XCD_BAR_WORDS 3456
#define XB_SPIN_CAP (1u << 18)

__device__ __forceinline__ unsigned xb_ld(unsigned* p)              { return __hip_atomic_load(p, __ATOMIC_RELAXED, __HIP_MEMORY_SCOPE_AGENT); }
__device__ __forceinline__ unsigned xb_add(unsigned* p, unsigned v) { return __hip_atomic_fetch_add(p, v, __ATOMIC_RELAXED, __HIP_MEMORY_SCOPE_AGENT); }
__device__ __forceinline__ unsigned xb_xcc_id() { return (unsigned)__builtin_amdgcn_s_getreg((3 << 11) | 20) & 0xFu; }
#define XB_SPIN(cond, bar) do { unsigned _sp = 0; while (cond) { __builtin_amdgcn_s_sleep(1); \
    if ((++_sp & 255u) == 0u) { if (xb_ld(&(bar)[XB_TMO])) break; if (_sp > XB_SPIN_CAP) { atomicAdd(&(bar)[XB_TMO], 1u); break; } } } } while (0)

struct XcdBarrier {
    unsigned* bar; unsigned x;
    volatile LAS unsigned* st;
};

__device__ __forceinline__ XcdBarrier xcd_barrier_post(unsigned* bar, volatile LAS unsigned* st) {
    XcdBarrier b; b.bar = bar; b.x = xb_xcc_id(); b.st = st;
    if (threadIdx.x == 0) (void)xb_add(&bar[XB_XCNT(b.x)], 1u);
    return b;
}
__device__ __forceinline__ void xcd_barrier_complete(unsigned* bar, unsigned x, unsigned& nloc, unsigned& nx) {
    const unsigned G = gridDim.x * gridDim.y * gridDim.z;
    unsigned sum, cnt, mine, sp = 0u;
    for (;;) {
        sum = 0u; cnt = 0u; mine = 0u;
#pragma unroll
        for (unsigned j = 0; j < 16; ++j) { const unsigned c = xb_ld(&bar[XB_XCNT(j)]); sum += c; cnt += (c > 0u) ? 1u : 0u; mine = (j == x) ? c : mine; }
        if (sum == G) break;
        __builtin_amdgcn_s_sleep(1);
        if ((++sp & 255u) == 0u) { if (xb_ld(&bar[XB_TMO])) break; if (sp > XB_SPIN_CAP) { atomicAdd(&bar[XB_TMO], 1u); break; } }
    }
    nloc = mine > 0u ? mine : 1u; nx = cnt > 0u ? cnt : 1u;
}

__device__ __forceinline__ void xcd_barrier(const XcdBarrier& b) {
    asm volatile("s_waitcnt vmcnt(0)" ::: "memory");
    __syncthreads();
    int xb_t0 = threadIdx.x; asm volatile("" : "+v"(xb_t0));
    if (xb_t0 == 0) {
        unsigned* bar = b.bar;
        __builtin_amdgcn_s_waitcnt(0);
        unsigned nloc = b.st[0], nx = b.st[1];
        if (nloc == 0u) { xcd_barrier_complete(bar, b.x, nloc, nx); b.st[0] = nloc; b.st[1] = nx; }
        const unsigned old = xb_add(&bar[XB_XSUB(b.x)], 1u);
        const unsigned gen = old / nloc;
        if (old + 1u == (gen + 1u) * nloc) {
            __builtin_amdgcn_fence(__ATOMIC_RELEASE, "agent");
            asm volatile("s_waitcnt vmcnt(0)" ::: "memory");
            const unsigned og = xb_add(&bar[XB_TOP], 1u);
            const unsigned tg = og / nx;
            if (og + 1u == (tg + 1u) * nx) xb_add(&bar[XB_TOPGEN], 1u);
            else XB_SPIN(xb_ld(&bar[XB_TOPGEN]) == tg, bar);
            __builtin_amdgcn_fence(__ATOMIC_ACQUIRE, "agent");
            xb_add(&bar[XB_XGEN(b.x)], 1u);
            asm volatile("s_waitcnt vmcnt(0)" ::: "memory");
        } else {
            XB_SPIN(xb_ld(&bar[XB_XGEN(b.x)]) == gen, bar);
            __builtin_amdgcn_fence(__ATOMIC_ACQUIRE, "agent");
            asm volatile("s_waitcnt vmcnt(0)" ::: "memory");
        }
    }
    __syncthreads();
}


__global__ void __launch_bounds__(NTHR, 2) hybrid_fwd(Params p0) {
    extern __shared__ __attribute__((aligned(16))) unsigned char lds_raw[];
    LAS unsigned char* lds = (LAS unsigned char*)lds_raw;
    cg::grid_group grid = cg::this_grid();
    if (p0.ws == nullptr) grid.sync();
    volatile LAS unsigned* xst = (volatile LAS unsigned*)(lds + 131072);
    if (threadIdx.x < 4) xst[threadIdx.x] = 0u;
    __syncthreads();
    const XcdBarrier xbar = xcd_barrier_post((unsigned*)(__attribute__((address_space(1))) unsigned*)(p0.ws + OFF_BAR), xst);
#define WSP(T, off) ((T*)(p.ws + (off)))
    { Params q = p0; q.ws = (unsigned char*)(__attribute__((address_space(1))) unsigned char*)p0.ws; q.in[0] = (const float*)(__attribute__((address_space(1))) const float*)p0.in[0]; q.in[1] = (const float*)(__attribute__((address_space(1))) const float*)p0.in[1]; phase_prologue_x(q); }
#pragma nounroll
    for (int ph = 0; ph < 14; ++ph) {
        int phl = ph; asm volatile("" : "+s"(phl));
        const int layer = phl >= 7 ? 1 : 0, k = phl - 7 * layer;
        int G_l = gridDim.x, c_l = blockIdx.x; asm volatile("" : "+s"(G_l), "+s"(c_l)); const int G = G_l, c = c_l;
        Params q = p0; { unsigned lo = (unsigned)((size_t)p0.ws), hi = (unsigned)((size_t)p0.ws >> 32); asm volatile("" : "+v"(lo), "+v"(hi)); lo = __builtin_amdgcn_readfirstlane(lo); hi = __builtin_amdgcn_readfirstlane(hi); q.ws = (unsigned char*)(__attribute__((address_space(1))) unsigned char*)(((size_t)hi << 32) | (size_t)lo);
#pragma unroll
          for (int i = 0; i < 23; ++i) q.in[i] = (const float*)(__attribute__((address_space(1))) const float*)p0.in[i];
          q.out = (float*)(__attribute__((address_space(1))) float*)p0.out; }
        const Params p = q; int ztid = threadIdx.x; asm volatile("" : "+v"(ztid));
#ifdef PROBE_K
        const unsigned long long tp0 = __builtin_amdgcn_s_memrealtime();
#endif
        switch (k) {
        case 0: phase_convert(lds, p, layer); break;
        case 1: {
            pg8::Gemm g{WSP(bf16_t, OFF_XW), WSP(bf16_t, OFF_W1A), MTOK, N1A, 1024}; pg8::StaticOrder S; S.init(MTOK, N1A, G, c);
            EpiG1a E{WSP(float, OFF_RSTD), WSP(bf16_t, OFF_SG), WSP(bf16_t, OFF_SG) + (size_t)MTOK * 1536, WSP(bf16_t, OFF_Y), WSP(bf16_t, OFF_Y) + (size_t)MTOK * 768, WSP(bf16_t, OFF_CU), WSP(bf16_t, OFF_SCZ), WSP(float, OFF_SMALL)};
            pg8::gemm_phase<EpiG1a, pg8::StaticOrder, false>(lds, g, S, E, nullptr); } break;
        case 2:
            for (int it = c; it < 2048; it += G) { if (it < 1024) mlstm_pre(lds, p, layer, it); else gla_pre(lds, p, layer, it - 1024); } break;
        case 3:
            for (int it = c; it < 256; it += G) {
                if (it < 96) mlstm_item(lds, p, layer, it);
                else if (it < 192) gla_item(lds, p, layer, it - 96);
                else { for (int k5 = 0; k5 < 2; ++k5) s5_item(lds, p, layer, it - 192 + 64 * k5); }
            } break;
        case 4: {
            { bf16_t* y2 = WSP(bf16_t, OFF_Y2); for (size_t i = (size_t)c * NTHR + ztid; i < (size_t)MTOK * 32; i += (size_t)G * NTHR) { const size_t row = i >> 5, seg = i & 31; *(u32x4*)(y2 + row * 768 + 512 + seg * 8) = (u32x4){0u, 0u, 0u, 0u}; } }
            { pg8::Gemm g{WSP(bf16_t, OFF_XW), WSP(bf16_t, OFF_W1B), MTOK, N1B, 1024}; pg8::StaticOrder S; S.init(MTOK, N1B, G, c);
              EpiG1b E{WSP(float, OFF_RSTD), WSP(bf16_t, OFF_Y), WSP(bf16_t, OFF_Y) + (size_t)MTOK * 768, WSP(bf16_t, OFF_SG), WSP(float, OFF_STA), WSP(float, OFF_STB), p.in[5] + (size_t)layer * 768, p.in[8] + (size_t)layer * 768};
              pg8::gemm_phase<EpiG1b, pg8::StaticOrder, false>(lds, g, S, E, nullptr); }
            { int Gl = G; asm volatile("" : "+s"(Gl)); const bool split = (Gl == 256); const int g2G = split ? 128 : G, g2c = split ? c - 128 : c;
              if (g2c >= 0) { pg8::Gemm g{WSP(bf16_t, OFF_CU), WSP(bf16_t, OFF_WGLU), MTOK, 512, 512}; pg8::StaticOrder S; S.init(MTOK, 512, g2G, g2c);
                  EpiG2 E{WSP(bf16_t, OFF_CU), WSP(bf16_t, OFF_SCZ), WSP(bf16_t, OFF_Y2)};
                  pg8::gemm_phase<EpiG2, pg8::StaticOrder, false>(lds, g, S, E, nullptr); } } } break;
        case 5: {
            pg8::Gemm g{WSP(bf16_t, OFF_Y), WSP(bf16_t, OFF_WBR), 3 * MTOK, 3 * 1024, 768}; BranchOrder S{G, c}; EpiG3 E{WSP(bf16_t, OFF_SG), WSP(bf16_t, OFF_MERGED)};
            pg8::gemm_phase<EpiG3, BranchOrder, false>(lds, g, S, E, nullptr); } break;
        default: {
            pg8::Gemm g{WSP(bf16_t, OFF_MERGED), WSP(bf16_t, OFF_WOUT), MTOK, 1024, 1024}; pg8::StaticOrder S; S.init(MTOK, 1024, G, c);
            EpiG4 E{layer == 0 ? p.in[0] : p.out, p.out, WSP(bf16_t, OFF_XW), layer == 0 ? p.in[1] + 1024 : p.in[22], WSP(float, OFF_RSS), layer == 0 ? 1 : 0};
            pg8::gemm_phase<EpiG4, pg8::StaticOrder, false>(lds, g, S, E, nullptr); } break;
        }
#ifdef PROBE_K
        if (k == PROBE_K) { const unsigned long long tp1 = __builtin_amdgcn_s_memrealtime(); while (__builtin_amdgcn_s_memrealtime() - tp1 < tp1 - tp0) __builtin_amdgcn_s_sleep(8); }
#endif
        xcd_barrier(xbar);
    }
    { Params p = p0; p.ws = (unsigned char*)(__attribute__((address_space(1))) unsigned char*)p0.ws; p.out = (float*)(__attribute__((address_space(1))) float*)p0.out; p.in[22] = (const float*)(__attribute__((address_space(1))) const float*)p0.in[22]; const int G = gridDim.x, c = blockIdx.x; int tid_l = threadIdx.x; asm volatile("" : "+v"(tid_l)); const int tid = tid_l, lane = tid & 63, wid = tid >> 6; const float* fn = p.in[22]; const float* RSS = WSP(float, OFF_RSS);
      f32x4 nv[4];
#pragma unroll
      for (int i = 0; i < 4; ++i) nv[i] = *(const f32x4*)(fn + i * 256 + lane * 4);
      for (int row = c * 8 + wid; row < MTOK; row += G * 8) { const float rs = row_rstd(RSS, row);
#pragma unroll
          for (int i = 0; i < 4; ++i) { float* op = p.out + (size_t)row * 1024 + i * 256 + lane * 4; const f32x4 v = *(const f32x4*)op; *(f32x4*)op = v * rs * nv[i]; } } }
#undef WSP
}

extern "C" void kernel_launch(void* const* d_in, const int* in_sizes, int n_in, void* d_out, int out_size, void* d_ws, size_t ws_size, hipStream_t stream) {
    static int grid_blocks = 0;
    if (grid_blocks == 0) {
        if (n_in != 23 || ws_size < WS_END) { fprintf(stderr, "kernel_launch: need 23 inputs and %zu bytes of workspace (got %d, %zu)\n", (size_t)WS_END, n_in, ws_size); grid_blocks = -1; return; }
        int dev = 0, cus = 0, per_cu = 0;
        hipGetDevice(&dev); hipDeviceGetAttribute(&cus, hipDeviceAttributeMultiprocessorCount, dev);
        if (hipFuncSetAttribute((const void*)hybrid_fwd, hipFuncAttributeMaxDynamicSharedMemorySize, LDS_BYTES) != hipSuccess) { fprintf(stderr, "kernel_launch: hipFuncSetAttribute failed\n"); grid_blocks = -1; return; }
        if (hipOccupancyMaxActiveBlocksPerMultiprocessor(&per_cu, (const void*)hybrid_fwd, NTHR, LDS_BYTES) != hipSuccess || per_cu < 1) per_cu = 1;
        (void)hipGetLastError();
        grid_blocks = cus * 1;
    }
    if (grid_blocks < 0) return;
    Params p{};
    for (int i = 0; i < 23; ++i) p.in[i] = (const float*)d_in[i];
    p.out = (float*)d_out; p.ws = (unsigned char*)d_ws;
    if (hipMemsetAsync((char*)d_ws + OFF_BAR, 0, BAR_BYTES, stream) != hipSuccess) { fprintf(stderr, "memset failed\n"); return; }
    void* args[] = {&p};
    hipError_t e = hipLaunchCooperativeKernel((const void*)hybrid_fwd, dim3(grid_blocks), dim3(NTHR), args, LDS_BYTES, stream);
    if (e != hipSuccess) fprintf(stderr, "cooperative launch failed: %s (grid %d)\n", hipGetErrorString(e), grid_blocks);
}
```

```cpp
#include <hip/hip_runtime.h>
#include <hip/hip_cooperative_groups.h>
#include <cstdio>
namespace cg = cooperative_groups;
namespace pg8 {
#define PG8_LAS __attribute__((address_space(3)))
typedef unsigned short bf16_t;
typedef short bf16x8 __attribute__((ext_vector_type(8)));
typedef float f32x4 __attribute__((ext_vector_type(4)));
typedef unsigned u32x4 __attribute__((ext_vector_type(4)));
constexpr int BM = 256, BK = 64, HALF = 128, HTB = HALF * BK * 2  , STAGE_BYTES = 8 * HTB, NXCD = 8, WGM = 8;

__host__ __device__ __forceinline__ int lds_byte(int r, int c) { const int st = (r >> 4) * 2 + (c >> 5), rr = r & 15, cc = c & 31, ob = rr * 64 + cc * 2; return st * 1024 + (ob ^ (((ob >> 9) & 1) << 5)); }
__host__ __device__ __forceinline__ void stage_rc(int b, int& R, int& C) { const int st = b / 1024, sb = b % 1024, swz = sb ^ (((sb >> 9) & 1) << 5); R = (st >> 1) * 16 + swz / 64; C = (st & 1) * 32 + (swz % 64) / 2; }
__host__ __device__ __forceinline__ int perm32(int rho) { const int n = rho >> 4, i = rho & 15; return 8 * (i >> 2) + 4 * n + (i & 3); }

struct Unit { int pm, pn; };
struct Gemm { const bf16_t* A; const bf16_t* Bt; int M, N, K; };

struct StaticOrder {
    int nM, nN, nwg, G, c;
    __host__ __device__ void init(int M, int N, int G_, int c_) { nM = M / BM; nN = N / BM; nwg = nM * nN; G = G_; c = c_; }
    __host__ __device__ bool next(int i, Unit& u) const {
        const long L = (long)i * G + c; if (L >= nwg) return false;
        int wgid = (int)L; { const int q = nwg / NXCD, r = nwg % NXCD, xcd = wgid % NXCD, off = wgid / NXCD; wgid = (xcd < r ? xcd * (q + 1) : r * (q + 1) + (xcd - r) * q) + off; }
        const int nig = WGM * nN, gid = wgid / nig, fm = gid * WGM, gsz = (nM - fm) < WGM ? (nM - fm) : WGM;
        u.pm = fm + ((wgid % nig) % gsz); u.pn = (wgid % nig) / gsz; return true;
    }
    __device__ __forceinline__ void a_ready(const Unit&) const {}
    __device__ __forceinline__ void done(const Unit&) const {}
};
typedef float f32x2c __attribute__((ext_vector_type(2)));
typedef __bf16 bf16x2c __attribute__((ext_vector_type(2)));
__device__ __forceinline__ unsigned cvt_pk_bf16(float lo, float hi) { const f32x2c v = {lo, hi}; const bf16x2c r = __builtin_convertvector(v, bf16x2c); return __builtin_bit_cast(unsigned, r); }
typedef float f32x2 __attribute__((ext_vector_type(2)));
template <class Epi, class Sched, bool STAMP = false>
__device__ __forceinline__ void gemm_phase(PG8_LAS unsigned char* lds, const Gemm g, const Sched& S, const Epi& E, unsigned long long* stamps) {
    int tid_l = threadIdx.x; asm volatile("" : "+v"(tid_l)); const int tid = tid_l, wid = __builtin_amdgcn_readfirstlane(tid >> 6), lane = tid & 63, wr = wid >> 2, wc = wid & 3, fr = lane & 15, fq = lane >> 4;
    const int K = g.K, nt = K / BK;
    int ts_lo = 0, ts_hi = 0, nts = 0; const unsigned long long rt_entry = STAMP ? (unsigned long long)wall_clock64() : 0ull;
#define PG8_STAMP() do { if (STAMP && wid == 0 && nts < 64) { const unsigned long long _c = (unsigned long long)clock64(); \
        ts_lo = (lane == nts) ? (int)(unsigned)_c : ts_lo; ts_hi = (lane == nts) ? (int)(unsigned)(_c >> 32) : ts_hi; ++nts; } } while (0)
    PG8_STAMP();
    unsigned voffA[2], voffB[2];
#pragma unroll
    for (int i = 0; i < 2; ++i) { int R, C; stage_rc(tid * 16 + i * 8192, R, C); const int Rb = Epi::PERM ? ((R & ~31) + perm32(R & 31)) : R;
        voffA[i] = (unsigned)(R * K + C) * 2u; voffB[i] = (unsigned)(Rb * K + C) * 2u; }
    const size_t kstep = (size_t)(BK * 2);
    const size_t hstep = (size_t)HALF * K * 2;
    const size_t tstep = 2 * hstep;
    const unsigned ldsw = (unsigned)wid * 1024u;
    const int aoff = lds_byte(wr * 64 + fr, fq * 8), boff = lds_byte(wc * 32 + fr, fq * 8);
#define PG8_SA(b, h) (((b) * 2 + (h)) * HTB)
#define PG8_SB(b, h) ((4 + (b) * 2 + (h)) * HTB)
#define PG8_STAGE(bufoff, gbase, voff) do { _Pragma("unroll") for (int _i = 0; _i < 2; ++_i) \
        __builtin_amdgcn_global_load_lds((const unsigned*)((const char*)(gbase) + (voff)[_i]), (PG8_LAS unsigned*)(lds + (bufoff) + ldsw + _i * 8192), 16, 0, 0); } while (0)
#define PG8_LDA(dst, b, h) do { _Pragma("unroll") for (int m = 0; m < 4; ++m) _Pragma("unroll") for (int k = 0; k < 2; ++k) dst[m][k] = *(const PG8_LAS bf16x8*)(lds + PG8_SA(b, h) + aoff + m * 2048 + k * 1024); } while (0)
#define PG8_LDB(dst, b, h) do { _Pragma("unroll") for (int n = 0; n < 2; ++n) _Pragma("unroll") for (int k = 0; k < 2; ++k) dst[n][k] = *(const PG8_LAS bf16x8*)(lds + PG8_SB(b, h) + boff + n * 2048 + k * 1024); } while (0)
#define PG8_MMA(ai, bj, At, Bt) do { __builtin_amdgcn_s_setprio(1); _Pragma("unroll") for (int m = 0; m < 4; ++m) _Pragma("unroll") for (int n = 0; n < 2; ++n) _Pragma("unroll") for (int k = 0; k < 2; ++k) \
        acc[ai][bj][m][n] = __builtin_amdgcn_mfma_f32_16x16x32_bf16(Bt[n][k], At[m][k], acc[ai][bj][m][n], 0, 0, 0); __builtin_amdgcn_s_setprio(0); } while (0)
#define PG8_WAIT_V(n) asm volatile("s_waitcnt vmcnt(" #n ")" ::: "memory")
#define PG8_WAIT_L(n) asm volatile("s_waitcnt lgkmcnt(" #n ")" ::: "memory")
#define PG8_BAR __builtin_amdgcn_s_barrier()
#define PG8_SCHED __builtin_amdgcn_sched_barrier(0)
    Unit cur, nxt; int ui = 0;
    if (!S.next(0, cur)) return;
    f32x4 acc[2][2][4][2];
#pragma unroll
    for (int a = 0; a < 2; ++a)
#pragma unroll
        for (int b = 0; b < 2; ++b)
#pragma unroll
            for (int m = 0; m < 4; ++m)
#pragma unroll
                for (int n = 0; n < 2; ++n) acc[a][b][m][n] = (f32x4){0.f, 0.f, 0.f, 0.f};
    bf16x8 At[4][2], B0[2][2], B1[2][2];
    const char* cA = (const char*)g.A + (size_t)cur.pm * tstep; const char* cB = (const char*)g.Bt + (size_t)cur.pn * tstep;
    S.a_ready(cur);
    PG8_STAGE(PG8_SB(0, 0), cB, voffB); PG8_STAGE(PG8_SA(0, 0), cA, voffA); PG8_STAGE(PG8_SB(0, 1), cB + hstep, voffB); PG8_STAGE(PG8_SA(0, 1), cA + hstep, voffA);
    if (wr == 1) PG8_BAR;
    PG8_WAIT_V(4); PG8_BAR;
    PG8_STAGE(PG8_SB(1, 0), cB + kstep, voffB); PG8_STAGE(PG8_SA(1, 0), cA + kstep, voffA); PG8_STAGE(PG8_SB(1, 1), cB + hstep + kstep, voffB);
    PG8_WAIT_V(6); PG8_BAR;
    PG8_STAMP();
    for (;;) {
        const bool has_next = S.next(ui + 1, nxt);
        const char* nA = has_next ? (const char*)g.A + (size_t)nxt.pm * tstep : cA; const char* nB = has_next ? (const char*)g.Bt + (size_t)nxt.pn * tstep : cB;
        for (int t = 0; t < nt; t += 2) {
            const bool last = (t == nt - 2);
            const char* a1 = cA + (size_t)(t + 1) * kstep;
            const char* a2 = last ? nA : cA + (size_t)(t + 2) * kstep; const char* b2 = last ? nB : cB + (size_t)(t + 2) * kstep;
            const char* a3 = a2 + kstep; const char* b3 = b2 + kstep;
            if (last && has_next) S.a_ready(nxt);
            PG8_LDB(B0, 0, 0); PG8_SCHED; PG8_LDA(At, 0, 0); PG8_STAGE(PG8_SA(1, 1), a1 + hstep, voffA);
            PG8_WAIT_L(8); PG8_BAR; PG8_WAIT_L(0); PG8_MMA(0, 0, At, B0); PG8_BAR; PG8_SCHED;
            PG8_LDB(B1, 0, 1); PG8_STAGE(PG8_SB(0, 0), b2, voffB);
            PG8_BAR; PG8_WAIT_L(0); PG8_MMA(0, 1, At, B1); PG8_BAR;
            PG8_LDA(At, 0, 1); PG8_STAGE(PG8_SA(0, 0), a2, voffA);
            PG8_BAR; PG8_WAIT_L(0); PG8_MMA(1, 0, At, B0); PG8_BAR; PG8_SCHED;
            PG8_STAGE(PG8_SB(0, 1), b2 + hstep, voffB);
            PG8_WAIT_V(6); PG8_BAR; PG8_MMA(1, 1, At, B1); PG8_BAR;
            PG8_LDB(B0, 1, 0); PG8_SCHED; PG8_LDA(At, 1, 0); PG8_STAGE(PG8_SA(0, 1), a2 + hstep, voffA);
            PG8_WAIT_L(8); PG8_BAR; PG8_WAIT_L(0); PG8_MMA(0, 0, At, B0); PG8_BAR; PG8_SCHED;
            PG8_LDB(B1, 1, 1); PG8_STAGE(PG8_SB(1, 0), b3, voffB);
            PG8_BAR; PG8_WAIT_L(0); PG8_MMA(0, 1, At, B1); PG8_BAR;
            PG8_LDA(At, 1, 1); PG8_STAGE(PG8_SA(1, 0), a3, voffA);
            PG8_BAR; PG8_WAIT_L(0); PG8_MMA(1, 0, At, B0); PG8_BAR; PG8_SCHED;
            PG8_STAGE(PG8_SB(1, 1), b3 + hstep, voffB);
            PG8_WAIT_V(6); PG8_BAR; PG8_MMA(1, 1, At, B1); PG8_BAR;
        }
        PG8_STAMP();
        if constexpr (!Epi::AFTER_DRAIN) { E(acc, cur, wr, wc, fr, fq); S.done(cur); }
        PG8_STAMP();
        if (!has_next) break;
#pragma unroll
        for (int a = 0; a < 2; ++a)
#pragma unroll
            for (int b = 0; b < 2; ++b)
#pragma unroll
                for (int m = 0; m < 4; ++m)
#pragma unroll
                    for (int n = 0; n < 2; ++n) acc[a][b][m][n] = (f32x4){0.f, 0.f, 0.f, 0.f};
        cur = nxt; cA = nA; cB = nB; ++ui;
    }
    PG8_WAIT_V(0);
    if (wr == 0) PG8_BAR;
    PG8_BAR;
    if constexpr (Epi::AFTER_DRAIN) { E.fused(acc, cur, wr, wc, fr, fq, lds, wid, lane); S.done(cur); }
    PG8_STAMP();
    if (STAMP && wid == 0) { stamps[lane] = lane < nts ? (((unsigned long long)(unsigned)ts_hi << 32) | (unsigned)ts_lo) : 0ull;
        if (lane == 62) stamps[62] = rt_entry; if (lane == 63) stamps[63] = (unsigned long long)wall_clock64(); }
#undef PG8_STAMP
#undef PG8_SA
#undef PG8_SB
#undef PG8_STAGE
#undef PG8_LDA
#undef PG8_LDB
#undef PG8_MMA
#undef PG8_WAIT_V
#undef PG8_WAIT_L
#undef PG8_BAR
#undef PG8_SCHED
}
}

#define LAS __attribute__((address_space(3)))
using pg8::bf16_t; using pg8::bf16x8; using pg8::f32x4; using pg8::u32x4; using pg8::Unit; using pg8::cvt_pk_bf16;
typedef unsigned u32x2 __attribute__((ext_vector_type(2)));
typedef float f32x2v __attribute__((ext_vector_type(2)));

constexpr int MTOK = 16384, DM = 1024, SEQ = 4096;
constexpr int NTHR = 512;
constexpr int LDS_BYTES = 131072 + 16;
constexpr int N1A = 5120, N1B = 5376;
constexpr int NSTAT = 6;
constexpr int NSTA = 2;

constexpr size_t OFF_W1A = 0;
constexpr size_t OFF_W1B = OFF_W1A + (size_t)N1A * 1024 * 2;
constexpr size_t OFF_WGLU = OFF_W1B + (size_t)N1B * 1024 * 2;
constexpr size_t OFF_WBR = OFF_WGLU + (size_t)512 * 512 * 2;
constexpr size_t OFF_WOUT = OFF_WBR + (size_t)3 * 1024 * 768 * 2;
constexpr size_t OFF_XW = OFF_WOUT + (size_t)1024 * 1024 * 2;
constexpr size_t OFF_RSS = OFF_XW + (size_t)MTOK * 1024 * 2;
constexpr size_t OFF_Y = OFF_RSS + (size_t)MTOK * 16 * 4;
constexpr size_t OFF_SG = OFF_Y + (size_t)3 * MTOK * 768 * 2;
constexpr size_t OFF_CU = OFF_SG + (size_t)MTOK * 3072 * 2;
constexpr size_t OFF_SCZ = OFF_CU + (size_t)MTOK * 512 * 2;
constexpr size_t OFF_SMALL = OFF_SCZ + (size_t)MTOK * 512 * 2;
constexpr size_t OFF_MERGED = OFF_SMALL + (size_t)MTOK * 32 * 4;
constexpr size_t OFF_STA = OFF_MERGED + (size_t)MTOK * 1024 * 2;
constexpr size_t OFF_STB = OFF_STA + (size_t)MTOK * 4 * NSTAT * 2 * 4;
constexpr size_t OFF_RSTD = OFF_STB + (size_t)MTOK * 4 * NSTAT * 4;
constexpr size_t OFF_BAR = OFF_RSTD + (size_t)MTOK * 4;
constexpr size_t BAR_BYTES = 16384;
constexpr size_t OFF_VG = OFF_BAR + BAR_BYTES;
constexpr int VGC = 42;
constexpr size_t WS_END = OFF_VG + (size_t)4 * VGC * 4 * 64 * 192 * 2;

struct Params { const float* in[23]; float* out; unsigned char* ws; };

__device__ __forceinline__ float bf2f(unsigned v) { return __uint_as_float(v << 16); }
__device__ __forceinline__ bf16_t f2bf(float f) { unsigned u = __float_as_uint(f); u += 0x7FFFu + ((u >> 16) & 1u); return (bf16_t)(u >> 16); }
__device__ __forceinline__ float sigmoidf_(float x) { return __builtin_amdgcn_rcpf(1.0f + __expf(-x)); }
__device__ __forceinline__ float siluf_(float x) { return x * sigmoidf_(x); }
__device__ __forceinline__ float logsigmoidf_(float x) { return fminf(x, 0.0f) - log1pf(__expf(-fabsf(x))); }
__device__ __forceinline__ float geluf_(float x) { const float u = 0.7978845608028654f * (x + 0.044715f * x * x * x); const float t = 1.0f - 2.0f * __builtin_amdgcn_rcpf(1.0f + __expf(2.0f * u)); return 0.5f * x * (1.0f + t); }
__device__ __forceinline__ void unpack8(const u32x4 w, float (&f)[8]) {
    f[0] = __uint_as_float(w.x << 16); f[1] = __uint_as_float(w.x & 0xffff0000u); f[2] = __uint_as_float(w.y << 16); f[3] = __uint_as_float(w.y & 0xffff0000u);
    f[4] = __uint_as_float(w.z << 16); f[5] = __uint_as_float(w.z & 0xffff0000u); f[6] = __uint_as_float(w.w << 16); f[7] = __uint_as_float(w.w & 0xffff0000u);
}
__device__ __forceinline__ u32x4 pack8(const float (&f)[8]) { u32x4 w; w.x = cvt_pk_bf16(f[0], f[1]); w.y = cvt_pk_bf16(f[2], f[3]); w.z = cvt_pk_bf16(f[4], f[5]); w.w = cvt_pk_bf16(f[6], f[7]); return w; }
__device__ __forceinline__ float row_rstd(const float* rss, int row) {
    const f32x4* p = (const f32x4*)(rss + (size_t)row * 16); const f32x4 a = p[0], b = p[1], c = p[2], d = p[3];
    const float s = ((a[0] + a[1]) + (a[2] + a[3])) + ((b[0] + b[1]) + (b[2] + b[3])) + ((c[0] + c[1]) + (c[2] + c[3])) + ((d[0] + d[1]) + (d[2] + d[3]));
    return rsqrtf(s * (1.0f / 1024.0f) + 1e-6f);
}

struct EpiG1a {
    static constexpr bool PERM = true, AFTER_DRAIN = false;
    const float* rss; bf16_t* aqk; bf16_t* bqk; bf16_t* y0; bf16_t* y1; bf16_t* cu; bf16_t* scz; float* small;
    __device__ __forceinline__ void operator()(const f32x4 (&acc)[2][2][4][2], const Unit& u, int wr, int wc, int fr, int fq) const {
        const int pn = u.pn; const int row0 = u.pm * 256 + wr * 64 + fr;
        if (pn == 19) {
            if (wc == 0) {
#pragma unroll
                for (int ai = 0; ai < 2; ++ai)
#pragma unroll
                    for (int m = 0; m < 4; ++m) { const int row = row0 + ai * 128 + m * 16; const float rs = rss[row]; float* rp = small + (size_t)row * 32 + 8 * fq;
                        *(f32x4*)(rp) = acc[ai][0][m][0] * rs; *(f32x4*)(rp + 4) = acc[ai][0][m][1] * rs; }
            }
            return;
        }
        bf16_t* base; int ldc, colt; bool act = false;
        if (pn < 6) { base = aqk; ldc = 1536; colt = pn * 256; }
        else if (pn < 9) { base = y0; ldc = 768; colt = (pn - 6) * 256; }
        else if (pn < 12) { base = bqk; ldc = 768; colt = (pn - 9) * 256; }
        else if (pn < 15) { base = y1; ldc = 768; colt = (pn - 12) * 256; }
        else if (pn < 17) { base = cu; ldc = 512; colt = (pn - 15) * 256; }
        else { base = scz; ldc = 512; colt = (pn - 17) * 256; act = true; }
        const int col0 = colt + wc * 32 + 8 * fq;
        float rs8[2][4];
#pragma unroll
        for (int ai = 0; ai < 2; ++ai)
#pragma unroll
            for (int m = 0; m < 4; ++m) rs8[ai][m] = rss[row0 + ai * 128 + m * 16];
        asm volatile("s_waitcnt vmcnt(0)" ::: "memory");
#pragma unroll
        for (int ai = 0; ai < 2; ++ai)
#pragma unroll
            for (int m = 0; m < 4; ++m) { const int row = row0 + ai * 128 + m * 16; const float rs = rs8[ai][m]; bf16_t* rowp = base + (size_t)row * ldc + col0;
#pragma unroll
                for (int bj = 0; bj < 2; ++bj) { f32x4 v0 = acc[ai][bj][m][0] * rs, v1 = acc[ai][bj][m][1] * rs;
                    if (act) {
#pragma unroll
                        for (int j = 0; j < 4; ++j) { v0[j] = siluf_(v0[j]); v1[j] = siluf_(v1[j]); } }
                    u32x4 w; w.x = cvt_pk_bf16(v0[0], v0[1]); w.y = cvt_pk_bf16(v0[2], v0[3]); w.z = cvt_pk_bf16(v1[0], v1[1]); w.w = cvt_pk_bf16(v1[2], v1[3]);
                    *(u32x4*)(rowp + bj * 128) = w; } }
    }
};
struct EpiG1b {
    static constexpr bool PERM = true, AFTER_DRAIN = false;
    const float* rss; bf16_t* y0; bf16_t* y1; bf16_t* sg; const float* sta; const float* stb; const float* anorm; const float* bnorm;
    __device__ __forceinline__ void operator()(const f32x4 (&acc)[2][2][4][2], const Unit& u, int wr, int wc, int fr, int fq) const {
        const int pn = u.pn; const int row0 = u.pm * 256 + wr * 64 + fr;
        if (pn < 6) {
            const int ch = pn * 128 + wc * 32 + 8 * fq, hd = ch / 192;
            float rs8[2][4];
#pragma unroll
            for (int ai = 0; ai < 2; ++ai)
#pragma unroll
                for (int m = 0; m < 4; ++m) rs8[ai][m] = rss[row0 + ai * 128 + m * 16];
            asm volatile("s_waitcnt vmcnt(0)" ::: "memory");
            u32x4 tk[2][4];
#pragma unroll
            for (int ai = 0; ai < 2; ++ai)
#pragma unroll
                for (int m = 0; m < 4; ++m) { const float rs = rs8[ai][m]; const f32x4 o0 = acc[ai][0][m][0] * rs, o1 = acc[ai][0][m][1] * rs, z0 = acc[ai][1][m][0] * rs, z1 = acc[ai][1][m][1] * rs; float t[8];
#pragma unroll
                    for (int j = 0; j < 4; ++j) { t[j] = sigmoidf_(o0[j]) * siluf_(z0[j]); t[4 + j] = sigmoidf_(o1[j]) * siluf_(z1[j]); }
                    tk[ai][m] = pack8(t); }
            asm volatile("" ::: "memory");
            float nw[8];
            { const f32x4 a = *(const f32x4*)(anorm + ch), b = *(const f32x4*)(anorm + ch + 4); nw[0] = a[0]; nw[1] = a[1]; nw[2] = a[2]; nw[3] = a[3]; nw[4] = b[0]; nw[5] = b[1]; nw[6] = b[2]; nw[7] = b[3]; }
#pragma unroll
            for (int ai = 0; ai < 2; ++ai) { f32x4 st4[4]; u32x4 hv4[4];
#pragma unroll
                for (int m = 0; m < 4; ++m) { const int row = row0 + ai * 128 + m * 16; st4[m] = *(const f32x4*)(sta + ((size_t)row * 4 + hd) * (NSTA * 2)); hv4[m] = *(const u32x4*)(y0 + (size_t)row * 768 + ch); }
                asm volatile("s_waitcnt vmcnt(0)" ::: "memory");
#pragma unroll
                for (int m = 0; m < 4; ++m) { const int row = row0 + ai * 128 + m * 16; const float s1 = st4[m][0] + st4[m][2], s2 = st4[m][1] + st4[m][3];
                    const float mean = s1 * (1.0f / 192.0f); const float var = fmaxf(s2 * (1.0f / 192.0f) - mean * mean, 0.0f); const float hr = rsqrtf(var + 1e-6f);
                    float hv[8], t[8], r[8]; unpack8(hv4[m], hv); unpack8(tk[ai][m], t);
#pragma unroll
                    for (int j = 0; j < 8; ++j) r[j] = t[j] * ((hv[j] - mean) * hr * nw[j]);
                    *(u32x4*)(y0 + (size_t)row * 768 + ch) = pack8(r); }
                asm volatile("" ::: "memory"); }
        } else if (pn < 9) {
#pragma unroll
            for (int bj = 0; bj < 2; ++bj) { const int ch = (pn - 6) * 256 + bj * 128 + wc * 32 + 8 * fq, hd = ch / 192;
                float nw[8];
                { const f32x4 a = *(const f32x4*)(bnorm + ch), b = *(const f32x4*)(bnorm + ch + 4); nw[0] = a[0]; nw[1] = a[1]; nw[2] = a[2]; nw[3] = a[3]; nw[4] = b[0]; nw[5] = b[1]; nw[6] = b[2]; nw[7] = b[3]; }
#pragma unroll
                for (int ai = 0; ai < 2; ++ai)
#pragma unroll
                    for (int m = 0; m < 4; ++m) { const int row = row0 + ai * 128 + m * 16; const float rs = rss[row];
                        const f32x2v* sp = (const f32x2v*)(stb + ((size_t)row * 4 + hd) * NSTAT); float s2 = 0.f;
#pragma unroll
                        for (int q = 0; q < NSTAT / 2; ++q) { const f32x2v t = sp[q]; s2 += t[0] + t[1]; }
                        const float hr = rsqrtf(s2 * (1.0f / 192.0f) + 1e-6f);
                        bf16_t* yp = y1 + (size_t)row * 768 + ch; float hv[8]; unpack8(*(const u32x4*)yp, hv);
                        const f32x4 z0 = acc[ai][bj][m][0] * rs, z1 = acc[ai][bj][m][1] * rs; float r[8];
#pragma unroll
                        for (int j = 0; j < 4; ++j) { r[j] = siluf_(z0[j]) * (hv[j] * hr * nw[j]); r[4 + j] = siluf_(z1[j]) * (hv[4 + j] * hr * nw[4 + j]); }
                        *(u32x4*)yp = pack8(r); asm volatile("" ::: "memory"); } }
        } else {
            const int col0 = (pn - 9) * 256 + wc * 32 + 8 * fq;
            float rs8[2][4];
#pragma unroll
            for (int ai = 0; ai < 2; ++ai)
#pragma unroll
                for (int m = 0; m < 4; ++m) rs8[ai][m] = rss[row0 + ai * 128 + m * 16];
            asm volatile("s_waitcnt vmcnt(0)" ::: "memory");
#pragma unroll
            for (int ai = 0; ai < 2; ++ai)
#pragma unroll
                for (int m = 0; m < 4; ++m) { const int row = row0 + ai * 128 + m * 16; const float rs = rs8[ai][m]; bf16_t* rowp = sg + (size_t)row * 3072 + col0;
#pragma unroll
                    for (int bj = 0; bj < 2; ++bj) { const f32x4 v0 = acc[ai][bj][m][0] * rs, v1 = acc[ai][bj][m][1] * rs; float r[8];
#pragma unroll
                        for (int j = 0; j < 4; ++j) { r[j] = sigmoidf_(v0[j]); r[4 + j] = sigmoidf_(v1[j]); }
                        *(u32x4*)(rowp + bj * 128) = pack8(r); } }
        }
    }
};
struct EpiG2 {
    static constexpr bool PERM = true, AFTER_DRAIN = false;
    const bf16_t* ycp; const bf16_t* scz; bf16_t* y2;
    __device__ __forceinline__ void operator()(const f32x4 (&acc)[2][2][4][2], const Unit& u, int wr, int wc, int fr, int fq) const {
        const int row0 = u.pm * 256 + wr * 64 + fr, col0 = u.pn * 256 + wc * 32 + 8 * fq;
#pragma unroll
        for (int ai = 0; ai < 2; ++ai)
#pragma unroll
            for (int m = 0; m < 4; ++m) { const int row = row0 + ai * 128 + m * 16;
#pragma unroll
                for (int bj = 0; bj < 2; ++bj) { const int col = col0 + bj * 128; float a[8], z[8], r[8];
                    unpack8(*(const u32x4*)(ycp + (size_t)row * 512 + col), a); unpack8(*(const u32x4*)(scz + (size_t)row * 512 + col), z);
                    const f32x4 v0 = acc[ai][bj][m][0], v1 = acc[ai][bj][m][1];
#pragma unroll
                    for (int j = 0; j < 4; ++j) { r[j] = a[j] * sigmoidf_(v0[j]) * z[j]; r[4 + j] = a[4 + j] * sigmoidf_(v1[j]) * z[4 + j]; }
                    *(u32x4*)(y2 + (size_t)row * 768 + col) = pack8(r); } asm volatile("" ::: "memory"); }
    }
};
struct EpiG3 {
    static constexpr bool PERM = true, AFTER_DRAIN = false;
    const bf16_t* sg; bf16_t* merged;
    __device__ __forceinline__ void operator()(const f32x4 (&acc)[2][2][4][2], const Unit& u, int wr, int wc, int fr, int fq) const {
        const int br = u.pm >> 6, pm = u.pm & 63, pn = u.pn & 3;
        const int row0 = pm * 256 + wr * 64 + fr, col0 = pn * 256 + wc * 32 + 8 * fq;
        u32x4 pk[2][4][2];
#pragma unroll
        for (int ai = 0; ai < 2; ++ai)
#pragma unroll
            for (int m = 0; m < 4; ++m)
#pragma unroll
                for (int bj = 0; bj < 2; ++bj) { const f32x4 v0 = acc[ai][bj][m][0], v1 = acc[ai][bj][m][1]; u32x4 w; w.x = cvt_pk_bf16(v0[0], v0[1]); w.y = cvt_pk_bf16(v0[2], v0[3]); w.z = cvt_pk_bf16(v1[0], v1[1]); w.w = cvt_pk_bf16(v1[2], v1[3]); pk[ai][m][bj] = w; }
#pragma unroll
        for (int ai = 0; ai < 2; ++ai) {
            u32x4 gq[4][2], pq[4][2];
#pragma unroll
            for (int m = 0; m < 4; ++m) { const int row = row0 + ai * 128 + m * 16;
#pragma unroll
                for (int bj = 0; bj < 2; ++bj) { gq[m][bj] = *(const u32x4*)(sg + (size_t)row * 3072 + br * 1024 + col0 + bj * 128); if (br != 0) pq[m][bj] = *(const u32x4*)(merged + (size_t)row * 1024 + col0 + bj * 128); } }
            asm volatile("s_waitcnt vmcnt(0)" ::: "memory");
#pragma unroll
            for (int m = 0; m < 4; ++m) { const int row = row0 + ai * 128 + m * 16;
#pragma unroll
                for (int bj = 0; bj < 2; ++bj) { u32x4 w; const u32x4 gv = gq[m][bj], av = pk[ai][m][bj], pvv = pq[m][bj];
#pragma unroll
                    for (int hq = 0; hq < 4; ++hq) { const unsigned gw = hq == 0 ? gv.x : hq == 1 ? gv.y : hq == 2 ? gv.z : gv.w, aw = hq == 0 ? av.x : hq == 1 ? av.y : hq == 2 ? av.z : av.w;
                        float r0 = __uint_as_float(gw << 16) * __uint_as_float(aw << 16), r1 = __uint_as_float(gw & 0xffff0000u) * __uint_as_float(aw & 0xffff0000u);
                        if (br != 0) { const unsigned pw = hq == 0 ? pvv.x : hq == 1 ? pvv.y : hq == 2 ? pvv.z : pvv.w; r0 += __uint_as_float(pw << 16); r1 += __uint_as_float(pw & 0xffff0000u); }
                        const unsigned o = cvt_pk_bf16(r0, r1); if (hq == 0) w.x = o; else if (hq == 1) w.y = o; else if (hq == 2) w.z = o; else w.w = o; }
                    *(u32x4*)(merged + (size_t)row * 1024 + col0 + bj * 128) = w; } }
            asm volatile("" ::: "memory"); }
    }
};
struct EpiG4 {
    static constexpr bool PERM = false, AFTER_DRAIN = false;
    const float* xprev; float* xnew; bf16_t* xw; const float* nwn; float* rss; int write_xw;
    __device__ __forceinline__ void operator()(const f32x4 (&acc)[2][2][4][2], const Unit& u, int wr, int wc, int fr, int fq) const {
        const int row0 = u.pm * 256 + wr * 64 + fr, col0 = u.pn * 256 + wc * 32 + 4 * fq;
        f32x4 nv[2][2];
#pragma unroll
        for (int bj = 0; bj < 2; ++bj)
#pragma unroll
            for (int n = 0; n < 2; ++n) nv[bj][n] = *(const f32x4*)(nwn + col0 + bj * 128 + n * 16);
#pragma unroll
        for (int ai = 0; ai < 2; ++ai)
#pragma unroll
            for (int mp = 0; mp < 2; ++mp) {
                f32x4 xr[2][2][2];
#pragma unroll
                for (int q = 0; q < 2; ++q) { const size_t off = (size_t)(row0 + ai * 128 + (2 * mp + q) * 16) * 1024 + col0;
#pragma unroll
                    for (int bj = 0; bj < 2; ++bj)
#pragma unroll
                        for (int n = 0; n < 2; ++n) xr[q][bj][n] = *(const f32x4*)(xprev + off + bj * 128 + n * 16); }
                asm volatile("s_waitcnt vmcnt(0)" ::: "memory");
#pragma unroll
                for (int q = 0; q < 2; ++q) { const int m = 2 * mp + q; const int row = row0 + ai * 128 + m * 16; const size_t off = (size_t)row * 1024 + col0; float ss = 0.f;
#pragma unroll
                    for (int bj = 0; bj < 2; ++bj)
#pragma unroll
                        for (int n = 0; n < 2; ++n) { const f32x4 xv = xr[q][bj][n] + acc[ai][bj][m][n];
                            *(f32x4*)(xnew + off + bj * 128 + n * 16) = xv; ss += (xv[0] * xv[0] + xv[1] * xv[1]) + (xv[2] * xv[2] + xv[3] * xv[3]);
                            if (write_xw) { const f32x4 t = xv * nv[bj][n]; u32x2 w; w.x = cvt_pk_bf16(t[0], t[1]); w.y = cvt_pk_bf16(t[2], t[3]); *(u32x2*)(xw + off + bj * 128 + n * 16) = w; } }
                    ss += __shfl_xor(ss, 16); ss += __shfl_xor(ss, 32);
                    if (fq == 0) rss[(size_t)row * 16 + u.pn * 4 + wc] = ss; }
                asm volatile("" ::: "memory"); }
    }
};
struct BranchOrder {
    int G, c;
    __device__ bool next(int i, Unit& u) const {
        const int j = i / 3, br = i - 3 * j; const long L = (long)j * G + c; if (L >= 256) return false;
        int wgid = (int)L; { const int q = 256 / 8, xcd = wgid % 8, off = wgid / 8; wgid = xcd * q + off; }
        const int nig = 8 * 4, gid = wgid / nig, fm = gid * 8; const int pm = fm + ((wgid % nig) % 8), pn = (wgid % nig) / 8;
        u.pm = br * 64 + pm; u.pn = br * 4 + pn; return true;
    }
    __device__ __forceinline__ void a_ready(const Unit&) const {}
    __device__ __forceinline__ void done(const Unit&) const {}
};

template <int KK> __device__ __forceinline__ f32x4 mma_tile(const LAS bf16_t* A, int lda, int r0, const LAS bf16_t* Bt, int ldb, int c0, f32x4 acc, int lane) {
    const int fr = lane & 15, fq = lane >> 4;
    const LAS bf16_t* ap = A + (r0 + fr) * lda + fq * 8; const LAS bf16_t* bp = Bt + (c0 + fr) * ldb + fq * 8;
#pragma unroll
    for (int k = 0; k < KK; k += 32) { const bf16x8 a = *(const LAS bf16x8*)(ap + k); const bf16x8 b = *(const LAS bf16x8*)(bp + k); acc = __builtin_amdgcn_mfma_f32_16x16x32_bf16(a, b, acc, 0, 0, 0); }
    return acc;
}
template <int CTRL, int RM> __device__ __forceinline__ float dpp_or(float oldv, float v) { return __int_as_float(__builtin_amdgcn_update_dpp(__float_as_int(oldv), __float_as_int(v), CTRL, RM, 0xF, false)); }
__device__ __forceinline__ float wave_scan_add(float v, int) {
    v += dpp_or<0x111, 0xF>(0.f, v); v += dpp_or<0x112, 0xF>(0.f, v); v += dpp_or<0x114, 0xF>(0.f, v); v += dpp_or<0x118, 0xF>(0.f, v);
    v += dpp_or<0x142, 0xA>(0.f, v); v += dpp_or<0x143, 0xC>(0.f, v); return v;
}
__device__ __forceinline__ float wave_scan_max(float v, int) {
    v = fmaxf(v, dpp_or<0x111, 0xF>(v, v)); v = fmaxf(v, dpp_or<0x112, 0xF>(v, v)); v = fmaxf(v, dpp_or<0x114, 0xF>(v, v)); v = fmaxf(v, dpp_or<0x118, 0xF>(v, v));
    v = fmaxf(v, dpp_or<0x142, 0xA>(v, v)); v = fmaxf(v, dpp_or<0x143, 0xC>(v, v)); return v;
}

template <int CTRL> __device__ __forceinline__ float dppf(float v) { return __int_as_float(__builtin_amdgcn_update_dpp(0, __float_as_int(v), CTRL, 0xF, 0xF, true)); }
__device__ __forceinline__ float rflf(float v) { return __int_as_float(__builtin_amdgcn_readfirstlane(__float_as_int(v))); }
__device__ __forceinline__ float quadsum(float v) { v += dppf<0xB1>(v); v += dppf<0x4E>(v); return v; }
__device__ __forceinline__ float rowsum16(float v) { v += dppf<0xB1>(v); v += dppf<0x4E>(v); v += dppf<0x141>(v); v += dppf<0x140>(v); return v; }
__device__ __forceinline__ float rowbcast4(float v, int r) { switch (r) { case 0: return dppf<0x150>(v); case 1: return dppf<0x154>(v); case 2: return dppf<0x158>(v); default: return dppf<0x15C>(v); } }
__device__ __forceinline__ int colmap(int type, int n) {
    if (type == 1) {
        if (n < 2304) return n;
        if (n < 3072) return 3848 + (n - 2304);
        if (n < 3840) return 4616 + (n - 3072);
        if (n < 4352) return 6168 + (n - 3840);
        if (n < 4864) return 6680 + (n - 4352);
        const int j = n - 4864; if (j < 4) return 3072 + j; if (j < 8) return 3076 + (j - 4); if (j < 24) return 5384 + (j - 8); return -1;
    }
    if (type == 2) {
        if (n < 1536) { const int t = n >> 8, hf = (n >> 7) & 1, x = n & 127; return (hf ? 3080 : 2304) + 128 * t + x; }
        if (n < 2304) return 5400 + (n - 1536);
        return 7192 + (n - 2304);
    }
    return n;
}
__device__ __forceinline__ void convert_job(LAS float* tl, const float* src, int lds_, int ks, bf16_t* dst, int kd, int nrows, int type, int G, int c) {
    int tid_l = threadIdx.x; asm volatile("" : "+v"(tid_l)); const int tid = tid_l; const int nkt = kd / 64, nnt = nrows / 64, ntiles = nkt * nnt;
    float pf[8];
#define CONV_LOAD(tt) do { const int kt_ = (tt) % nkt, nt_ = (tt) / nkt; const int k0_ = kt_ * 64, n0_ = nt_ * 64; const int sc_ = colmap(type, n0_ + (tid & 63)); \
        _Pragma("unroll") for (int i_ = 0; i_ < 8; ++i_) { const int kk_ = (tid >> 6) + 8 * i_; float v_ = 0.f; if (sc_ >= 0 && (k0_ + kk_) < ks) v_ = src[(size_t)(k0_ + kk_) * lds_ + sc_]; pf[i_] = v_; } } while (0)
    if (c < ntiles) CONV_LOAD(c);
    for (int t = c; t < ntiles; t += G) {
        const int kt = t % nkt, nt = t / nkt; const int k0 = kt * 64, n0 = nt * 64;
        asm volatile("s_waitcnt vmcnt(0)" ::: "memory");
        { const int nn = tid & 63;
#pragma unroll
          for (int i = 0; i < 8; ++i) { const int kk = (tid >> 6) + 8 * i; tl[nn * 65 + kk] = pf[i]; } }
        if (t + G < ntiles) CONV_LOAD(t + G);
        __syncthreads();
        { const int nn = tid >> 3, kseg = tid & 7; float f[8];
#pragma unroll
          for (int j = 0; j < 8; ++j) f[j] = tl[nn * 65 + kseg * 8 + j];
          *(u32x4*)(dst + (size_t)(n0 + nn) * kd + k0 + kseg * 8) = pack8(f); }
        __syncthreads();
    }
#undef CONV_LOAD
}
__device__ __forceinline__ void phase_convert(LAS unsigned char* lds, const Params p, int layer) {
    LAS float* tl = (LAS float*)lds; const int G = gridDim.x, c = blockIdx.x; unsigned char* ws = p.ws;
    const float* w_in = p.in[2] + (size_t)layer * 1024 * 10264;
    convert_job(tl, w_in, 10264, 1024, (bf16_t*)(ws + OFF_W1A), 1024, N1A, 1, G, c);
    convert_job(tl, w_in, 10264, 1024, (bf16_t*)(ws + OFF_W1B), 1024, N1B, 2, G, c);
    convert_job(tl, p.in[17] + (size_t)layer * 512 * 512, 512, 512, (bf16_t*)(ws + OFF_WGLU), 512, 512, 0, G, c);
    convert_job(tl, p.in[18] + (size_t)layer * 768 * 1024, 1024, 768, (bf16_t*)(ws + OFF_WBR), 768, 1024, 0, G, c);
    convert_job(tl, p.in[19] + (size_t)layer * 768 * 1024, 1024, 768, (bf16_t*)(ws + OFF_WBR) + (size_t)1024 * 768, 768, 1024, 0, G, c);
    convert_job(tl, p.in[20] + (size_t)layer * 512 * 1024, 1024, 512, (bf16_t*)(ws + OFF_WBR) + (size_t)2 * 1024 * 768, 768, 1024, 0, G, c);
    convert_job(tl, p.in[21] + (size_t)layer * 1024 * 1024, 1024, 1024, (bf16_t*)(ws + OFF_WOUT), 1024, 1024, 0, G, c);
    if (layer > 0) { const float* rss = (const float*)(ws + OFF_RSS); float* rstd = (float*)(ws + OFF_RSTD); int t2 = threadIdx.x; asm volatile("" : "+v"(t2)); for (int row = c * NTHR + t2; row < MTOK; row += G * NTHR) rstd[row] = row_rstd(rss, row); }
}
__device__ __forceinline__ void phase_prologue_x(const Params p) {
    int tid_l = threadIdx.x; asm volatile("" : "+v"(tid_l)); const int tid = tid_l, lane = tid & 63, wid = tid >> 6; const int G = gridDim.x; unsigned char* ws = p.ws;
    const float* x = p.in[0]; const float* nw = p.in[1]; bf16_t* xw = (bf16_t*)(ws + OFF_XW); float* rstd = (float*)(ws + OFF_RSTD);
    f32x4 nv[4];
#pragma unroll
    for (int i = 0; i < 4; ++i) nv[i] = *(const f32x4*)(nw + i * 256 + lane * 4);
    for (int row = blockIdx.x * 8 + wid; row < MTOK; row += G * 8) {
        float ss = 0.f;
#pragma unroll
        for (int i = 0; i < 4; ++i) { const f32x4 v = *(const f32x4*)(x + (size_t)row * 1024 + i * 256 + lane * 4); ss += (v[0] * v[0] + v[1] * v[1]) + (v[2] * v[2] + v[3] * v[3]);
            const f32x4 t = v * nv[i]; u32x2 w; w.x = cvt_pk_bf16(t[0], t[1]); w.y = cvt_pk_bf16(t[2], t[3]); *(u32x2*)(xw + (size_t)row * 1024 + i * 256 + lane * 4) = w; }
#pragma unroll
        for (int o = 32; o >= 1; o >>= 1) ss += __shfl_xor(ss, o);
        if (lane == 0) rstd[row] = rsqrtf(ss * (1.0f / 1024.0f) + 1e-6f);
    }
}

constexpr size_t OFF_QG = OFF_MERGED;
constexpr size_t OFF_SCO = OFF_MERGED + (size_t)MTOK * 768 * 2;
constexpr size_t OFF_KTG = OFF_SG + (size_t)MTOK * 2304 * 2;
constexpr size_t OFF_Y2 = OFF_Y + (size_t)2 * MTOK * 768 * 2;
constexpr size_t OFF_KTB = OFF_Y2;
constexpr size_t OFF_PGB = OFF_KTB + (size_t)1024 * 96 * 64 * 2;
constexpr size_t OFF_ELAST = OFF_PGB + (size_t)1024 * 64 * 64 * 2;
constexpr size_t OFF_GT = OFF_ELAST + (size_t)1024 * 96 * 4;
constexpr size_t OFF_CHS = OFF_GT + (size_t)1024 * 3 * 64 * 4;
static_assert(OFF_CHS + 1024 * 2 * 4 <= OFF_Y2 + (size_t)MTOK * 768 * 2, "Y[2] scratch overflow");

__device__ __forceinline__ void mlstm_pre(LAS unsigned char* lds, const Params p, int layer, int item) {
    int tid_l = threadIdx.x; asm volatile("" : "+v"(tid_l)); const int tid = tid_l, lane = tid & 63, wid = __builtin_amdgcn_readfirstlane(tid >> 6), fr = lane & 15, fq = lane >> 4;
    const int h = item & 3, ci = item >> 2, c = ci & 63, b = ci >> 6, row0 = ci * 64;
    unsigned char* ws = p.ws;
    const bf16_t* aqk = (const bf16_t*)(ws + OFF_SG); const float* small = (const float*)(ws + OFF_SMALL);
    bf16_t* qg = (bf16_t*)(ws + OFF_QG); bf16_t* sco = (bf16_t*)(ws + OFF_SCO) + (size_t)item * 4096; bf16_t* ktg = (bf16_t*)(ws + OFF_KTG) + (size_t)item * 192 * 64;
    float* gt = (float*)(ws + OFF_GT) + (size_t)item * 192; float* chs = (float*)(ws + OFF_CHS) + item * 2;
    const float* convw = p.in[3] + (size_t)layer * 4 * 1536; const float bi = p.in[4][layer * 8 + h], bfg = p.in[4][layer * 8 + 4 + h];
    LAS bf16_t* Qs = (LAS bf16_t*)lds; LAS bf16_t* Ks = Qs + 64 * 200;
    const float kscale = 0.07216878364870322f;
    if (wid == 0) {
        const float ip = small[(size_t)(row0 + lane) * 32 + h] + bi; const float fp = small[(size_t)(row0 + lane) * 32 + 4 + h] + bfg;
        const float bc = wave_scan_add(logsigmoidf_(fp), lane); const float g = ip - bc; const float cm = wave_scan_max(g, lane);
        gt[lane] = g; gt[64 + lane] = cm; gt[128 + lane] = bc;
        if (lane == 63) { chs[0] = bc; chs[1] = cm; }
    }
    u32x4 qws[3];
#pragma unroll
    for (int kt = 0; kt < 3; ++kt) { const int task = tid + NTHR * kt;
        const int t = task / 24, d8 = task - t * 24; const int ch = h * 192 + d8 * 8;
        float aq[8], ak[8];
#pragma unroll
        for (int j = 0; j < 8; ++j) { aq[j] = 0.f; ak[j] = 0.f; }
#pragma unroll
        for (int tap = 0; tap < 4; ++tap) { const int tt = c * 64 + t - 3 + tap;
            if (tt >= 0) { const bf16_t* rp = aqk + (size_t)(b * SEQ + tt) * 1536 + ch; float rq[8], rk[8]; unpack8(*(const u32x4*)rp, rq); unpack8(*(const u32x4*)(rp + 768), rk);
                const float* wq = convw + tap * 1536 + ch; const f32x4 q0 = *(const f32x4*)wq, q1 = *(const f32x4*)(wq + 4), k0 = *(const f32x4*)(wq + 768), k1 = *(const f32x4*)(wq + 772);
#pragma unroll
                for (int j = 0; j < 4; ++j) { aq[j] += q0[j] * rq[j]; aq[4 + j] += q1[j] * rq[4 + j]; ak[j] += k0[j] * rk[j]; ak[4 + j] += k1[j] * rk[4 + j]; } } }
#pragma unroll
        for (int j = 0; j < 8; ++j) { aq[j] = siluf_(aq[j]); ak[j] = siluf_(ak[j]) * kscale; }
        const u32x4 qw = pack8(aq);
        *(LAS u32x4*)(Qs + t * 200 + d8 * 8) = qw; *(LAS u32x4*)(Ks + t * 200 + d8 * 8) = pack8(ak);
        qws[kt] = qw;
    }
    asm volatile("s_waitcnt vmcnt(0)" ::: "memory");
#pragma unroll
    for (int kt = 0; kt < 3; ++kt) { const int task = tid + NTHR * kt; const int t = task / 24, d8 = task - t * 24; *(u32x4*)(qg + (size_t)(row0 + t) * 768 + h * 192 + d8 * 8) = qws[kt]; }
    if (c < VGC) { const bf16_t* y0 = (const bf16_t*)(ws + OFF_Y); bf16_t* vg = (bf16_t*)(ws + OFF_VG) + (size_t)((b * VGC + c) * 4 + h) * 12288;
#pragma unroll
        for (int k = 0; k < 3; ++k) { const int i = tid + NTHR * k; const int t = i / 24, d8 = i - t * 24; *(u32x4*)(vg + t * 192 + d8 * 8) = *(const u32x4*)(y0 + (size_t)(row0 + t) * 768 + h * 192 + d8 * 8); } }
    __syncthreads();
    { const int tr = wid >> 1;
#pragma unroll
      for (int q = 0; q < 2; ++q) { const int tc = (wid & 1) * 2 + q; f32x4 a = (f32x4){0.f, 0.f, 0.f, 0.f};
          if (tc <= tr) a = mma_tile<192>(Qs, 200, 16 * tr, Ks, 200, 16 * tc, a, lane);
          const int s = 16 * tc + fr;
#pragma unroll
          for (int r = 0; r < 4; ++r) { const int t = 16 * tr + 4 * fq + r; sco[t * 64 + s] = f2bf((s <= t) ? a[r] : 0.f); } } }
    for (int task = tid; task < 192 * 8; task += NTHR) { const int s8 = task / 192, d = task - s8 * 192; float f[8];
#pragma unroll
        for (int j = 0; j < 8; ++j) f[j] = bf2f(Ks[(s8 * 8 + j) * 200 + d]);
        *(u32x4*)(ktg + d * 64 + s8 * 8) = pack8(f); }
    __syncthreads();
}

__device__ __forceinline__ void gla_pre(LAS unsigned char* lds, const Params p, int layer, int item) {
    int tid_l = threadIdx.x; asm volatile("" : "+v"(tid_l)); const int tid = tid_l, lane = tid & 63, wid = __builtin_amdgcn_readfirstlane(tid >> 6), fr = lane & 15, fq = lane >> 4;
    const int h = item & 3, ci = item >> 2, row0 = ci * 64;
    unsigned char* ws = p.ws;
    bf16_t* bqk = (bf16_t*)(ws + OFF_SG) + (size_t)MTOK * 1536; const float* small = (const float*)(ws + OFF_SMALL);
    bf16_t* ktb = (bf16_t*)(ws + OFF_KTB) + (size_t)item * 96 * 64; bf16_t* pgb = (bf16_t*)(ws + OFF_PGB) + (size_t)item * 4096; float* elast = (float*)(ws + OFF_ELAST) + item * 96;
    const float* walpha = p.in[6] + (size_t)layer * 16 * 384; const float* balpha = p.in[7] + (size_t)layer * 384;
    LAS bf16_t* Qs = (LAS bf16_t*)lds; LAS bf16_t* Ks = Qs + 64 * 104; LAS float* Bc = (LAS float*)(Ks + 64 * 104); LAS float* BAs = Bc + 64 * 97;
    const int gd = tid % 96, gtq = tid / 96; float wal[16]; float bal = 0.f;
    if (tid < 384) {
#pragma unroll
        for (int r = 0; r < 16; ++r) wal[r] = walpha[r * 384 + h * 96 + gd];
        bal = balpha[h * 96 + gd]; }
    const float qscale = 0.10206207261596575f;
    u32x4 rq[2], rk[2];
#pragma unroll
    for (int k = 0; k < 2; ++k) { const int task = tid + NTHR * k; if (task < 768) { const int t = task / 12, d8 = task - t * 12; const bf16_t* rp = bqk + (size_t)(row0 + t) * 768 + h * 96 + d8 * 8; rq[k] = *(const u32x4*)rp; rk[k] = *(const u32x4*)(rp + 384); } }
    for (int i = tid; i < 64 * 4; i += NTHR) { const int t = i >> 2, q = i & 3; *(LAS f32x4*)(BAs + t * 16 + q * 4) = *(const f32x4*)(small + (size_t)(row0 + t) * 32 + 8 + q * 4); }
    __syncthreads();
    if (tid < 384) {
#pragma unroll 4
        for (int i = 0; i < 16; ++i) { const int t = gtq * 16 + i; float z = bal;
#pragma unroll
            for (int r = 0; r < 16; ++r) z += BAs[t * 16 + r] * wal[r];
            Bc[t * 97 + gd] = logsigmoidf_(z) * (1.0f / 16.0f); } }
    __syncthreads();
    for (int i = 0; i < 12; ++i) { const int d = wid * 12 + i; const float v = wave_scan_add(Bc[lane * 97 + d], lane); Bc[lane * 97 + d] = v; }
    __syncthreads();
    asm volatile("s_waitcnt vmcnt(0)" ::: "memory");
#pragma unroll
    for (int kk = 0; kk < 2; ++kk) { const int task = tid + NTHR * kk; if (task >= 768) continue;
        const int t = task / 12, d8 = task - t * 12; bf16_t* rp = bqk + (size_t)(row0 + t) * 768 + h * 96 + d8 * 8; float q[8], k[8];
        unpack8(rq[kk], q); unpack8(rk[kk], k);
#pragma unroll
        for (int j = 0; j < 8; ++j) { const float bc = Bc[t * 97 + d8 * 8 + j]; q[j] = q[j] * qscale * __expf(bc); k[j] = k[j] * __expf(-bc); }
        const u32x4 qw = pack8(q);
        *(LAS u32x4*)(Qs + t * 104 + d8 * 8) = qw; *(LAS u32x4*)(Ks + t * 104 + d8 * 8) = pack8(k);
        *(u32x4*)rp = qw;
    }
    if (tid < 96) elast[tid] = __expf(Bc[63 * 97 + tid]);
    __syncthreads();
    { const int tr = wid >> 1;
#pragma unroll
      for (int q = 0; q < 2; ++q) { const int tc = (wid & 1) * 2 + q; f32x4 a = (f32x4){0.f, 0.f, 0.f, 0.f};
          if (tc <= tr) a = mma_tile<96>(Qs, 104, 16 * tr, Ks, 104, 16 * tc, a, lane);
          const int s = 16 * tc + fr;
#pragma unroll
          for (int r = 0; r < 4; ++r) { const int t = 16 * tr + 4 * fq + r; pgb[t * 64 + s] = f2bf((s <= t) ? a[r] : 0.f); } } }
    for (int task = tid; task < 96 * 8; task += NTHR) { const int s8 = task / 96, d = task - s8 * 96; float f[8];
#pragma unroll
        for (int j = 0; j < 8; ++j) f[j] = bf2f(Ks[(s8 * 8 + j) * 104 + d]);
        *(u32x4*)(ktb + d * 64 + s8 * 8) = pack8(f); }
    __syncthreads();
}

__device__ __forceinline__ void mlstm_item(LAS unsigned char* lds, const Params p, int layer, int item) {
    int tid_l = threadIdx.x; asm volatile("" : "+v"(tid_l)); const int tid = tid_l, lane = tid & 63, wid = __builtin_amdgcn_readfirstlane(tid >> 6), fr = lane & 15, fq = lane >> 4;
    const int seqhalf = item % 3, half = (item / 3) & 1, bh = item / 6, h = bh & 3, b = bh >> 2, e_base = half * 96;
    const int cout0 = seqhalf == 0 ? 0 : (seqhalf == 1 ? 21 : 42), cend = seqhalf == 0 ? 21 : (seqhalf == 1 ? 42 : 64);
    unsigned char* ws = p.ws;
    bf16_t* y0 = (bf16_t*)(ws + OFF_Y); float* sta = (float*)(ws + OFF_STA);
    const bf16_t* qg = (const bf16_t*)(ws + OFF_QG); const bf16_t* sco = (const bf16_t*)(ws + OFF_SCO); const bf16_t* ktg = (const bf16_t*)(ws + OFF_KTG);
    const float* gt = (const float*)(ws + OFF_GT); const float* chs = (const float*)(ws + OFF_CHS); const bf16_t* vg = (const bf16_t*)(ws + OFF_VG);
    LAS bf16_t* Qs = (LAS bf16_t*)lds; LAS bf16_t* KTw = Qs + 64 * 200; LAS bf16_t* VTs = KTw + 192 * 72; LAS bf16_t* Ss = VTs + 96 * 72; LAS bf16_t* CTs = Ss + 64 * 72;
    LAS float* fv = (LAS float*)(CTs + 96 * 200);
    LAS float* cmS = fv; LAS float* bcS = fv + 64; LAS float* dinvS = fv + 128; LAS float* wintS = fv + 192; LAS float* nv0 = fv + 256; LAS float* nv1 = nv0 + 192; LAS float* stS = nv1 + 192;
    for (int i = tid; i < 384; i += NTHR) nv0[i] = 0.f;
    f32x4 cacc[12];
#pragma unroll
    for (int i = 0; i < 12; ++i) cacc[i] = (f32x4){0.f, 0.f, 0.f, 0.f};
    float mstate = 0.f;
    u32x4 pq[3], pk[3], ps; u32x2 pv[3]; float pg8v[8], pcm, pcm2 = 0.f, pbc2 = 0.f; float pbend, pgmax;
    const int st_t = tid >> 3, st_s8 = tid & 7;
#define MLSTM_PREFETCH(cc) do { const int ch_ = ((b * 64 + (cc)) * 4 + h); const int r0_ = b * SEQ + (cc) * 64; \
        const bool vc_ = (cc) < cout0; const bf16_t* vb_ = vc_ ? vg + (size_t)((b * VGC + (cc)) * 4 + h) * 12288 + e_base : y0 + (size_t)r0_ * 768 + h * 192 + e_base; const int vp_ = vc_ ? 192 : 768; \
        _Pragma("unroll") for (int k_ = 0; k_ < 3; ++k_) { const int i_ = tid + NTHR * k_; const int t_ = i_ / 24, d8_ = i_ - t_ * 24; if ((cc) >= cout0) pq[k_] = *(const u32x4*)(qg + (size_t)(r0_ + t_) * 768 + h * 192 + d8_ * 8); \
            pk[k_] = *(const u32x4*)(ktg + (size_t)ch_ * 12288 + (size_t)i_ * 8); \
            pv[k_] = *(const u32x2*)(vb_ + (size_t)t_ * vp_ + d8_ * 4); } \
        if ((cc) >= cout0) ps = *(const u32x4*)(sco + (size_t)ch_ * 4096 + st_t * 64 + st_s8 * 8); \
        { const f32x4 ga_ = *(const f32x4*)(gt + (size_t)ch_ * 192 + st_s8 * 8), gb_ = *(const f32x4*)(gt + (size_t)ch_ * 192 + st_s8 * 8 + 4); \
          pg8v[0] = ga_[0]; pg8v[1] = ga_[1]; pg8v[2] = ga_[2]; pg8v[3] = ga_[3]; pg8v[4] = gb_[0]; pg8v[5] = gb_[1]; pg8v[6] = gb_[2]; pg8v[7] = gb_[3]; } \
        pcm = gt[(size_t)ch_ * 192 + 64 + st_t]; \
        if (tid < 64) { pcm2 = gt[(size_t)ch_ * 192 + 64 + tid]; pbc2 = gt[(size_t)ch_ * 192 + 128 + tid]; } \
        pbend = chs[ch_ * 2]; pgmax = chs[ch_ * 2 + 1]; } while (0)
    MLSTM_PREFETCH(0);
    __syncthreads();
    for (int c = 0; c < cend; ++c) {
        const int row0 = b * SEQ + c * 64; const bool do_out = (c >= cout0);
        LAS float* ncur = (c & 1) ? nv1 : nv0; LAS float* nnext = (c & 1) ? nv0 : nv1;
        asm volatile("s_waitcnt vmcnt(0)" ::: "memory");
        const float mx = rflf(fmaxf(mstate, pgmax)); const float mnew = rflf(pbend + mx); const float wprev = rflf(__expf(mstate - mx)); const float mcur = mstate;
        { float wk8[8];
#pragma unroll
          for (int j = 0; j < 8; ++j) wk8[j] = __expf(pg8v[j] - mx);
#pragma unroll
          for (int k = 0; k < 3; ++k) { const int i = tid + NTHR * k; const int t = i / 24, d8 = i - t * 24; if (do_out) *(LAS u32x4*)(Qs + t * 200 + d8 * 8) = pq[k];
              const int d = i >> 3; float f[8]; unpack8(pk[k], f);
#pragma unroll
              for (int j = 0; j < 8; ++j) f[j] *= wk8[j];
              *(LAS u32x4*)(KTw + d * 72 + st_s8 * 8) = pack8(f);
              const int ve = d8 * 4; VTs[(ve + 0) * 72 + t] = (bf16_t)(pv[k].x & 0xffffu); VTs[(ve + 1) * 72 + t] = (bf16_t)(pv[k].x >> 16); VTs[(ve + 2) * 72 + t] = (bf16_t)(pv[k].y & 0xffffu); VTs[(ve + 3) * 72 + t] = (bf16_t)(pv[k].y >> 16); }
          if (do_out) { float f[8]; unpack8(ps, f); const float mm = fmaxf(mcur, pcm);
#pragma unroll
            for (int j = 0; j < 8; ++j) f[j] = (st_s8 * 8 + j <= st_t) ? f[j] * __expf(pg8v[j] - mm) : 0.f;
            *(LAS u32x4*)(Ss + st_t * 72 + st_s8 * 8) = pack8(f); } }
        if (tid < 64) { cmS[tid] = pcm2; bcS[tid] = pbc2; }
        if (wid < 6 && do_out) {
#pragma unroll
            for (int dc = 0; dc < 12; ++dc) { u32x2 w; w.x = cvt_pk_bf16(cacc[dc][0], cacc[dc][1]); w.y = cvt_pk_bf16(cacc[dc][2], cacc[dc][3]); *(LAS u32x2*)(CTs + (16 * wid + fr) * 200 + 16 * dc + 4 * fq) = w; } }
        if (c + 1 < cend) MLSTM_PREFETCH(c + 1);
        __syncthreads();
        f32x4 onum[4];
        if (wid < 6) {
            const LAS bf16_t* vtp = VTs + (16 * wid + fr) * 72 + 8 * fq; const bf16x8 vt0 = *(const LAS bf16x8*)vtp, vt1 = *(const LAS bf16x8*)(vtp + 32);
#pragma unroll
            for (int dc = 0; dc < 12; ++dc) { const LAS bf16_t* kp = KTw + (16 * dc + fr) * 72 + 8 * fq; const bf16x8 a0 = *(const LAS bf16x8*)kp, a1 = *(const LAS bf16x8*)(kp + 32);
                cacc[dc] = cacc[dc] * wprev; cacc[dc] = __builtin_amdgcn_mfma_f32_16x16x32_bf16(a0, vt0, cacc[dc], 0, 0, 0); cacc[dc] = __builtin_amdgcn_mfma_f32_16x16x32_bf16(a1, vt1, cacc[dc], 0, 0, 0);
                if ((dc & 3) == 3) asm volatile("" ::: "memory"); }
            const LAS bf16_t* ctp = CTs + (16 * wid + fr) * 200 + 8 * fq;
            if (do_out) {
#pragma unroll
            for (int tr = 0; tr < 4; ++tr) { f32x4 a = (f32x4){0.f, 0.f, 0.f, 0.f}; const LAS bf16_t* qp = Qs + (16 * tr + fr) * 200 + 8 * fq;
#pragma unroll
                for (int k = 0; k < 6; ++k) a = __builtin_amdgcn_mfma_f32_16x16x32_bf16(*(const LAS bf16x8*)(qp + 32 * k), *(const LAS bf16x8*)(ctp + 32 * k), a, 0, 0, 0);
#pragma unroll
                for (int r = 0; r < 4; ++r) { const float cmv = cmS[16 * tr + 4 * fq + r]; a[r] *= __expf(mcur - fmaxf(mcur, cmv)); }
                const LAS bf16_t* sp = Ss + (16 * tr + fr) * 72 + 8 * fq;
                a = __builtin_amdgcn_mfma_f32_16x16x32_bf16(*(const LAS bf16x8*)sp, vt0, a, 0, 0, 0); a = __builtin_amdgcn_mfma_f32_16x16x32_bf16(*(const LAS bf16x8*)(sp + 32), vt1, a, 0, 0, 0);
                onum[tr] = a; asm volatile("" ::: "memory"); } }
        } else {
            const int ht = tid - 384, row = ht >> 1, hf = ht & 1; float rs = 0.f, qn = 0.f;
            if (do_out) {
#pragma unroll
            for (int i = 0; i < 4; ++i) { float f[8]; unpack8(*(const LAS u32x4*)(Ss + row * 72 + hf * 32 + i * 8), f); rs += ((f[0] + f[1]) + (f[2] + f[3])) + ((f[4] + f[5]) + (f[6] + f[7])); }
#pragma unroll
            for (int i = 0; i < 12; ++i) { float f[8]; unpack8(*(const LAS u32x4*)(Qs + row * 200 + hf * 96 + i * 8), f);
#pragma unroll
                for (int j = 0; j < 8; ++j) qn += f[j] * ncur[hf * 96 + i * 8 + j]; }
            rs += dppf<0xB1>(rs); qn += dppf<0xB1>(qn);
            const float mm = fmaxf(mcur, cmS[row]); const float wint = __expf(mcur - mm); const float emt = __expf(-(bcS[row] + mm));
            const float den = rs + wint * qn; const float dinv = 1.0f / fmaxf(fabsf(den), emt);
            if (hf == 0) { dinvS[row] = dinv; wintS[row] = wint; } }
#pragma unroll
            for (int rep = 0; rep < 2; ++rep) { const int d = ht + 128 * rep; if (d < 192) { float s = 0.f;
#pragma unroll
                for (int i = 0; i < 8; ++i) { float f[8]; unpack8(*(const LAS u32x4*)(KTw + d * 72 + i * 8), f); s += ((f[0] + f[1]) + (f[2] + f[3])) + ((f[4] + f[5]) + (f[6] + f[7])); }
                nnext[d] = wprev * ncur[d] + s; } }
            if (c > cout0 && ht < 64) { float s1 = 0.f, s2 = 0.f;
#pragma unroll
                for (int w = 0; w < 6; ++w) { s1 += stS[(w * 64 + ht) * 2]; s2 += stS[(w * 64 + ht) * 2 + 1]; }
                *(f32x2v*)(sta + (((size_t)(row0 - 64 + ht) * 4 + h) * NSTA + half) * 2) = (f32x2v){s1, s2}; }
        }
        mstate = mnew;
        __syncthreads();
        if (wid < 6 && do_out) {
#pragma unroll
            for (int tr = 0; tr < 4; ++tr) { float s1[4], s2[4];
#pragma unroll
                for (int r = 0; r < 4; ++r) { const int t = 16 * tr + 4 * fq + r; const float o = onum[tr][r] * dinvS[t];
                    y0[(size_t)(row0 + t) * 768 + h * 192 + e_base + 16 * wid + fr] = f2bf(o);
                    s1[r] = rowsum16(o); s2[r] = rowsum16(o * o); }
                if (fr == 0) {
#pragma unroll
                    for (int r = 0; r < 4; ++r) { const int t = 16 * tr + 4 * fq + r; *(LAS f32x2v*)(stS + (wid * 64 + t) * 2) = (f32x2v){s1[r], s2[r]}; } }
                asm volatile("" ::: "memory"); }
        }
    }
    __syncthreads();
    if (tid < 64) { const int row0 = b * SEQ + (cend - 1) * 64; float s1 = 0.f, s2 = 0.f;
#pragma unroll
        for (int w = 0; w < 6; ++w) { s1 += stS[(w * 64 + tid) * 2]; s2 += stS[(w * 64 + tid) * 2 + 1]; }
        *(f32x2v*)(sta + (((size_t)(row0 + tid) * 4 + h) * NSTA + half) * 2) = (f32x2v){s1, s2}; }
    __syncthreads();
#undef MLSTM_PREFETCH
}

__device__ __forceinline__ void gla_item(LAS unsigned char* lds, const Params p, int layer, int item) {
    int tid_l = threadIdx.x; asm volatile("" : "+v"(tid_l)); const int tid = tid_l, lane = tid & 63, wid = __builtin_amdgcn_readfirstlane(tid >> 6), fr = lane & 15, fq = lane >> 4;
    const int es = item % 6, bh = item / 6, h = bh & 3, b = bh >> 2, e0 = es * 32;
    unsigned char* ws = p.ws;
    const bf16_t* bqk = (const bf16_t*)(ws + OFF_SG) + (size_t)MTOK * 1536; bf16_t* y1 = (bf16_t*)(ws + OFF_Y) + (size_t)MTOK * 768; float* stb = (float*)(ws + OFF_STB);
    const bf16_t* ktb = (const bf16_t*)(ws + OFF_KTB); const bf16_t* pgb = (const bf16_t*)(ws + OFF_PGB); const float* elast = (const float*)(ws + OFF_ELAST);
    LAS bf16_t* Qs = (LAS bf16_t*)lds; LAS bf16_t* KTs = Qs + 64 * 104; LAS bf16_t* VTs = KTs + 96 * 72; LAS bf16_t* Ss = VTs + 32 * 72; LAS bf16_t* STs = Ss + 64 * 72;
    LAS float* elS = (LAS float*)(STs + 32 * 104); LAS float* stx = elS + 96;
    f32x4 sacc[2]; sacc[0] = (f32x4){0.f, 0.f, 0.f, 0.f}; sacc[1] = (f32x4){0.f, 0.f, 0.f, 0.f};
    float st2[4];
    u32x4 pq[2], pk[2], ps; u32x2 pv; float pel = 0.f;
    const int st_t = tid >> 3, st_s8 = tid & 7, vs = tid >> 3, ve = (tid & 7) * 4;
#define GLA_PREFETCH(cc) do { const int ch_ = ((b * 64 + (cc)) * 4 + h); const int r0_ = b * SEQ + (cc) * 64; \
        _Pragma("unroll") for (int k_ = 0; k_ < 2; ++k_) { const int i_ = tid + NTHR * k_; if (i_ < 768) { const int t_ = i_ / 12, d8_ = i_ - t_ * 12; pq[k_] = *(const u32x4*)(bqk + (size_t)(r0_ + t_) * 768 + h * 96 + d8_ * 8); \
            pk[k_] = *(const u32x4*)(ktb + (size_t)ch_ * 6144 + (size_t)i_ * 8); } } \
        ps = *(const u32x4*)(pgb + (size_t)ch_ * 4096 + st_t * 64 + st_s8 * 8); \
        if (tid < 96) pel = elast[ch_ * 96 + tid]; \
        pv = *(const u32x2*)(y1 + (size_t)(r0_ + vs) * 768 + h * 192 + e0 + ve); } while (0)
    GLA_PREFETCH(0);
    __syncthreads();
    for (int c = 0; c < 64; ++c) {
        const int row0 = b * SEQ + c * 64;
        asm volatile("s_waitcnt vmcnt(0)" ::: "memory");
#pragma unroll
        for (int k = 0; k < 2; ++k) { const int i = tid + NTHR * k; if (i < 768) { const int t = i / 12, d8 = i - t * 12; *(LAS u32x4*)(Qs + t * 104 + d8 * 8) = pq[k];
            const int d = i >> 3, s8 = i & 7; *(LAS u32x4*)(KTs + d * 72 + s8 * 8) = pk[k]; } }
        *(LAS u32x4*)(Ss + st_t * 72 + st_s8 * 8) = ps;
        VTs[(ve + 0) * 72 + vs] = (bf16_t)(pv.x & 0xffffu); VTs[(ve + 1) * 72 + vs] = (bf16_t)(pv.x >> 16); VTs[(ve + 2) * 72 + vs] = (bf16_t)(pv.y & 0xffffu); VTs[(ve + 3) * 72 + vs] = (bf16_t)(pv.y >> 16);
        if (tid < 96) elS[tid] = pel;
        if (wid < 6) {
#pragma unroll
            for (int er = 0; er < 2; ++er)
#pragma unroll
                for (int r = 0; r < 4; ++r) STs[(16 * er + 4 * fq + r) * 104 + 16 * wid + fr] = f2bf(sacc[er][r]); }
        if (c > 0 && (wid & 1) == 0 && fr == 0) {
#pragma unroll
            for (int r = 0; r < 4; ++r) { const int tt = 16 * (wid >> 1) + 4 * fq + r; stb[((size_t)(row0 - 64 + tt) * 4 + h) * NSTAT + es] = st2[r] + stx[tt]; } }
        if (c + 1 < 64) GLA_PREFETCH(c + 1);
        __syncthreads();
        { const int tr = wid >> 1, ec = wid & 1; f32x4 o = (f32x4){0.f, 0.f, 0.f, 0.f};
          o = mma_tile<64>(Ss, 72, 16 * tr, VTs, 72, 16 * ec, o, lane);
          o = mma_tile<96>(Qs, 104, 16 * tr, STs, 104, 16 * ec, o, lane);
#pragma unroll
          for (int r = 0; r < 4; ++r) { const int tt = 16 * tr + 4 * fq + r; y1[(size_t)(row0 + tt) * 768 + h * 192 + e0 + 16 * ec + fr] = f2bf(o[r]);
              const float s2 = rowsum16(o[r] * o[r]);
              if (fr == 0) { if (ec) stx[tt] = s2; else st2[r] = s2; } } }
        if (wid < 6) { const float dec = elS[16 * wid + fr];
#pragma unroll
            for (int er = 0; er < 2; ++er) { sacc[er] = mma_tile<64>(VTs, 72, 16 * er, KTs, 72, 16 * wid, sacc[er], lane); sacc[er] = sacc[er] * dec; } }
        __syncthreads();
    }
    if ((wid & 1) == 0 && fr == 0) { const int row0 = b * SEQ + 63 * 64;
#pragma unroll
        for (int r = 0; r < 4; ++r) { const int tt = 16 * (wid >> 1) + 4 * fq + r; stb[((size_t)(row0 + tt) * 4 + h) * NSTAT + es] = st2[r] + stx[tt]; } }
    __syncthreads();
#undef GLA_PREFETCH
}


__device__ __forceinline__ void cmul(float ar, float ai, float br, float bi, float& cr, float& ci) { cr = ar * br - ai * bi; ci = ar * bi + ai * br; }
__device__ __forceinline__ void s5_item(LAS unsigned char* lds, const Params p, int layer, int item) {
    int tid_l = threadIdx.x; asm volatile("" : "+v"(tid_l)); const int tid = tid_l, lane = tid & 63, wid = __builtin_amdgcn_readfirstlane(tid >> 6), fr = lane & 15, fq = lane >> 4;
    const int g = item & 31, b = item >> 5; unsigned char* ws = p.ws;
    bf16_t* cu = (bf16_t*)(ws + OFF_CU);
    const float* lam_re = p.in[9] + (size_t)layer * 2048 + g * 64; const float* lam_im = p.in[10] + (size_t)layer * 2048 + g * 64; const float ldt = p.in[11][layer * 32 + g];
    const float* Bre = p.in[12] + ((size_t)layer * 32 + g) * 1024; const float* Bim = p.in[13] + ((size_t)layer * 32 + g) * 1024;
    const float* Cre = p.in[14] + ((size_t)layer * 32 + g) * 1024; const float* Cim = p.in[15] + ((size_t)layer * 32 + g) * 1024;
    const float dsk = p.in[16][layer * 512 + g * 16 + fr];
    LAS float* BU = (LAS float*)(lds + wid * 12288);
    LAS bf16_t* Xs = (LAS bf16_t*)(lds + wid * 12288 + 8192);
    LAS float* Es = (LAS float*)(lds + 8 * 12288);
    const float dt = __expf(ldt);
    float are, aim;
    { const float lr = fminf(lam_re[lane], -1e-4f), li = lam_im[lane]; const float mag = __expf(lr * dt); are = mag * cosf(li * dt); aim = mag * sinf(li * dt); }
    bf16x8 bbop[8];
#pragma unroll
    for (int ct = 0; ct < 8; ++ct) { const int ps = 16 * (ct & 3) + fr, cc = ct >> 2; float f[8];
        const float lr = fminf(lam_re[ps], -1e-4f), li = lam_im[ps]; const float mag = __expf(lr * dt); const float abr = mag * cosf(li * dt), abi = mag * sinf(li * dt);
        const float nr = abr - 1.0f, den = lr * lr + li * li; const float cre = (nr * lr + abi * li) / den, cim = (abi * lr - nr * li) / den;
#pragma unroll
        for (int j = 0; j < 8; ++j) { float v = 0.f; if (fq < 2) { const float br = Bre[ps * 16 + 8 * fq + j], bi = Bim[ps * 16 + 8 * fq + j]; v = cc ? (cre * bi + cim * br) : (cre * br - cim * bi); } f[j] = v; }
        const u32x4 w = pack8(f); bbop[ct] = *(const bf16x8*)&w; }
    bf16x8 cmop[4];
#pragma unroll
    for (int ks = 0; ks < 4; ++ks) { float f[8];
#pragma unroll
        for (int j = 0; j < 8; ++j) { const int pp = 32 * ks + 8 * fq + j, ps = pp >> 1; f[j] = (pp & 1) ? -Cim[fr * 64 + ps] : Cre[fr * 64 + ps]; }
        const u32x4 w = pack8(f); cmop[ks] = *(const bf16x8*)&w; }
    const int seg0 = b * SEQ + wid * 512;
    float xr = 0.f, xi = 0.f;
    for (int pass = 0; pass < 2; ++pass) {
        u32x4 aw_n = (u32x4){0u, 0u, 0u, 0u}; bf16_t uv_n[4] = {0, 0, 0, 0};
        if (fq < 2) aw_n = *(const u32x4*)(cu + (size_t)(seg0 + fr) * 512 + g * 16 + 8 * fq);
        if (pass) {
#pragma unroll
            for (int r = 0; r < 4; ++r) uv_n[r] = cu[(size_t)(seg0 + 4 * fq + r) * 512 + g * 16 + fr]; }
        float of[16];
        for (int tile4 = 0; tile4 < 8; ++tile4) {
#pragma unroll
        for (int tq = 0; tq < 4; ++tq) { const int tile = tile4 * 4 + tq;
            const int r0 = seg0 + tile * 16;
            asm volatile("s_waitcnt vmcnt(0)" ::: "memory");
            const u32x4 aw = aw_n; const bf16x8 aop = *(const bf16x8*)&aw; bf16_t uvc[4];
#pragma unroll
            for (int r = 0; r < 4; ++r) uvc[r] = uv_n[r];
            if (tile + 1 < 32) { if (fq < 2) aw_n = *(const u32x4*)(cu + (size_t)(r0 + 16 + fr) * 512 + g * 16 + 8 * fq);
                if (pass) {
#pragma unroll
                    for (int r = 0; r < 4; ++r) uv_n[r] = cu[(size_t)(r0 + 16 + 4 * fq + r) * 512 + g * 16 + fr]; } }
#pragma unroll
            for (int ct = 0; ct < 4; ++ct) { f32x4 are_ = (f32x4){0.f, 0.f, 0.f, 0.f}, aim_ = (f32x4){0.f, 0.f, 0.f, 0.f};
                are_ = __builtin_amdgcn_mfma_f32_16x16x32_bf16(aop, bbop[ct], are_, 0, 0, 0); aim_ = __builtin_amdgcn_mfma_f32_16x16x32_bf16(aop, bbop[ct + 4], aim_, 0, 0, 0);
#pragma unroll
                for (int r = 0; r < 4; ++r) *(LAS f32x2v*)(BU + (4 * fq + r) * 128 + 2 * (16 * ct + fr)) = (f32x2v){are_[r], aim_[r]}; }
#pragma unroll
            for (int t = 0; t < 16; ++t) { const f32x2v bu = *(const LAS f32x2v*)(BU + t * 128 + 2 * lane); const float nr = are * xr - aim * xi + bu.x, ni = are * xi + aim * xr + bu.y; xr = nr; xi = ni;
                if (pass) *(LAS unsigned*)(Xs + t * 128 + 2 * lane) = cvt_pk_bf16(xr, xi); }
            if (pass) {
                f32x4 y = (f32x4){0.f, 0.f, 0.f, 0.f};
#pragma unroll
                for (int ks = 0; ks < 4; ++ks) { const bf16x8 xa = *(const LAS bf16x8*)(Xs + fr * 128 + 32 * ks + 8 * fq); y = __builtin_amdgcn_mfma_f32_16x16x32_bf16(xa, cmop[ks], y, 0, 0, 0); }
#pragma unroll
                for (int r = 0; r < 4; ++r) { const float uv = bf2f(uvc[r]); of[tq * 4 + r] = geluf_(y[r] + dsk * uv); }
            }
        }
        if (pass) {
#pragma unroll
            for (int tq = 0; tq < 4; ++tq)
#pragma unroll
                for (int r = 0; r < 4; ++r) cu[(size_t)(seg0 + (tile4 * 4 + tq) * 16 + 4 * fq + r) * 512 + g * 16 + fr] = f2bf(of[tq * 4 + r]); }
        }
        if (pass == 0) {
            Es[(wid * 64 + lane) * 2] = xr; Es[(wid * 64 + lane) * 2 + 1] = xi;
            __syncthreads();
            float pr = are, pi = aim;
#pragma unroll
            for (int i = 0; i < 9; ++i) { float tr, ti; cmul(pr, pi, pr, pi, tr, ti); pr = tr; pi = ti; }
            xr = 0.f; xi = 0.f;
            for (int w = 0; w < wid; ++w) { float tr, ti; cmul(pr, pi, xr, xi, tr, ti); xr = tr + Es[(w * 64 + lane) * 2]; xi = ti + Es[(w * 64 + lane) * 2 + 1]; }
        }
    }
    __syncthreads();
}

#define XB_TMO      128
#define XB_XCNT(j)  (256  + 64 * (j))
#define XB_XSUB(j)  (1280 + 64 * (j))
#define XB_XGEN(j)  (2304 + 64 * (j))
#define XB_TOP      3328
#define XB_TOPGEN   3392
#define XCD_BAR_WORDS 3456
#define XB_SPIN_CAP (1u << 18)

__device__ __forceinline__ unsigned xb_ld(unsigned* p)              { return __hip_atomic_load(p, __ATOMIC_RELAXED, __HIP_MEMORY_SCOPE_AGENT); }
__device__ __forceinline__ unsigned xb_add(unsigned* p, unsigned v) { return __hip_atomic_fetch_add(p, v, __ATOMIC_RELAXED, __HIP_MEMORY_SCOPE_AGENT); }
__device__ __forceinline__ unsigned xb_xcc_id() { return (unsigned)__builtin_amdgcn_s_getreg((3 << 11) | 20) & 0xFu; }
#define XB_SPIN(cond, bar) do { unsigned _sp = 0; while (cond) { __builtin_amdgcn_s_sleep(1); \
    if ((++_sp & 255u) == 0u) { if (xb_ld(&(bar)[XB_TMO])) break; if (_sp > XB_SPIN_CAP) { atomicAdd(&(bar)[XB_TMO], 1u); break; } } } } while (0)

struct XcdBarrier {
    unsigned* bar; unsigned x;
    volatile LAS unsigned* st;
};

__device__ __forceinline__ XcdBarrier xcd_barrier_post(unsigned* bar, volatile LAS unsigned* st) {
    XcdBarrier b; b.bar = bar; b.x = xb_xcc_id(); b.st = st;
    if (threadIdx.x == 0) (void)xb_add(&bar[XB_XCNT(b.x)], 1u);
    return b;
}
__device__ __forceinline__ void xcd_barrier_complete(unsigned* bar, unsigned x, unsigned& nloc, unsigned& nx) {
    const unsigned G = gridDim.x * gridDim.y * gridDim.z;
    unsigned sum, cnt, mine, sp = 0u;
    for (;;) {
        sum = 0u; cnt = 0u; mine = 0u;
#pragma unroll
        for (unsigned j = 0; j < 16; ++j) { const unsigned c = xb_ld(&bar[XB_XCNT(j)]); sum += c; cnt += (c > 0u) ? 1u : 0u; mine = (j == x) ? c : mine; }
        if (sum == G) break;
        __builtin_amdgcn_s_sleep(1);
        if ((++sp & 255u) == 0u) { if (xb_ld(&bar[XB_TMO])) break; if (sp > XB_SPIN_CAP) { atomicAdd(&bar[XB_TMO], 1u); break; } }
    }
    nloc = mine > 0u ? mine : 1u; nx = cnt > 0u ? cnt : 1u;
}

__device__ __forceinline__ void xcd_barrier(const XcdBarrier& b) {
    asm volatile("s_waitcnt vmcnt(0)" ::: "memory");
    __syncthreads();
    int xb_t0 = threadIdx.x; asm volatile("" : "+v"(xb_t0));
    if (xb_t0 == 0) {
        unsigned* bar = b.bar;
        __builtin_amdgcn_s_waitcnt(0);
        unsigned nloc = b.st[0], nx = b.st[1];
        if (nloc == 0u) { xcd_barrier_complete(bar, b.x, nloc, nx); b.st[0] = nloc; b.st[1] = nx; }
        const unsigned old = xb_add(&bar[XB_XSUB(b.x)], 1u);
        const unsigned gen = old / nloc;
        if (old + 1u == (gen + 1u) * nloc) {
            __builtin_amdgcn_fence(__ATOMIC_RELEASE, "agent");
            asm volatile("s_waitcnt vmcnt(0)" ::: "memory");
            const unsigned og = xb_add(&bar[XB_TOP], 1u);
            const unsigned tg = og / nx;
            if (og + 1u == (tg + 1u) * nx) xb_add(&bar[XB_TOPGEN], 1u);
            else XB_SPIN(xb_ld(&bar[XB_TOPGEN]) == tg, bar);
            __builtin_amdgcn_fence(__ATOMIC_ACQUIRE, "agent");
            xb_add(&bar[XB_XGEN(b.x)], 1u);
            asm volatile("s_waitcnt vmcnt(0)" ::: "memory");
        } else {
            XB_SPIN(xb_ld(&bar[XB_XGEN(b.x)]) == gen, bar);
            __builtin_amdgcn_fence(__ATOMIC_ACQUIRE, "agent");
            asm volatile("s_waitcnt vmcnt(0)" ::: "memory");
        }
    }
    __syncthreads();
}


__global__ void __launch_bounds__(NTHR, 2) hybrid_fwd(Params p0) {
    extern __shared__ __attribute__((aligned(16))) unsigned char lds_raw[];
    LAS unsigned char* lds = (LAS unsigned char*)lds_raw;
    cg::grid_group grid = cg::this_grid();
    if (p0.ws == nullptr) grid.sync();
    volatile LAS unsigned* xst = (volatile LAS unsigned*)(lds + 131072);
    if (threadIdx.x < 4) xst[threadIdx.x] = 0u;
    __syncthreads();
    const XcdBarrier xbar = xcd_barrier_post((unsigned*)(__attribute__((address_space(1))) unsigned*)(p0.ws + OFF_BAR), xst);
#define WSP(T, off) ((T*)(p.ws + (off)))
    { Params q = p0; q.ws = (unsigned char*)(__attribute__((address_space(1))) unsigned char*)p0.ws; q.in[0] = (const float*)(__attribute__((address_space(1))) const float*)p0.in[0]; q.in[1] = (const float*)(__attribute__((address_space(1))) const float*)p0.in[1]; phase_prologue_x(q); }
#pragma nounroll
    for (int ph = 0; ph < 14; ++ph) {
        int phl = ph; asm volatile("" : "+s"(phl));
        const int layer = phl >= 7 ? 1 : 0, k = phl - 7 * layer;
        int G_l = gridDim.x, c_l = blockIdx.x; asm volatile("" : "+s"(G_l), "+s"(c_l)); const int G = G_l, c = c_l;
        Params q = p0; { unsigned lo = (unsigned)((size_t)p0.ws), hi = (unsigned)((size_t)p0.ws >> 32); asm volatile("" : "+v"(lo), "+v"(hi)); lo = __builtin_amdgcn_readfirstlane(lo); hi = __builtin_amdgcn_readfirstlane(hi); q.ws = (unsigned char*)(__attribute__((address_space(1))) unsigned char*)(((size_t)hi << 32) | (size_t)lo);
#pragma unroll
          for (int i = 0; i < 23; ++i) q.in[i] = (const float*)(__attribute__((address_space(1))) const float*)p0.in[i];
          q.out = (float*)(__attribute__((address_space(1))) float*)p0.out; }
        const Params p = q; int ztid = threadIdx.x; asm volatile("" : "+v"(ztid));
#ifdef PROBE_K
        const unsigned long long tp0 = __builtin_amdgcn_s_memrealtime();
#endif
        switch (k) {
        case 0: phase_convert(lds, p, layer); break;
        case 1: {
            pg8::Gemm g{WSP(bf16_t, OFF_XW), WSP(bf16_t, OFF_W1A), MTOK, N1A, 1024}; pg8::StaticOrder S; S.init(MTOK, N1A, G, c);
            EpiG1a E{WSP(float, OFF_RSTD), WSP(bf16_t, OFF_SG), WSP(bf16_t, OFF_SG) + (size_t)MTOK * 1536, WSP(bf16_t, OFF_Y), WSP(bf16_t, OFF_Y) + (size_t)MTOK * 768, WSP(bf16_t, OFF_CU), WSP(bf16_t, OFF_SCZ), WSP(float, OFF_SMALL)};
            pg8::gemm_phase<EpiG1a, pg8::StaticOrder, false>(lds, g, S, E, nullptr); } break;
        case 2:
            for (int it = c; it < 2048; it += G) { if (it < 1024) mlstm_pre(lds, p, layer, it); else gla_pre(lds, p, layer, it - 1024); } break;
        case 3:
            for (int it = c; it < 256; it += G) {
                if (it < 96) mlstm_item(lds, p, layer, (it & 15) * 6 + (it >> 4));
                else if (it < 192) gla_item(lds, p, layer, ((it - 96) & 15) * 6 + ((it - 96) >> 4));
                else { const int cs = it - 192; const int s5i = (cs & 7) * 8 + (cs >> 3);
                       for (int k5 = 0; k5 < 2; ++k5) s5_item(lds, p, layer, s5i + 64 * k5); }
            } break;
        case 4: {
            { bf16_t* y2 = WSP(bf16_t, OFF_Y2); for (size_t i = (size_t)c * NTHR + ztid; i < (size_t)MTOK * 32; i += (size_t)G * NTHR) { const size_t row = i >> 5, seg = i & 31; *(u32x4*)(y2 + row * 768 + 512 + seg * 8) = (u32x4){0u, 0u, 0u, 0u}; } }
            { pg8::Gemm g{WSP(bf16_t, OFF_XW), WSP(bf16_t, OFF_W1B), MTOK, N1B, 1024}; pg8::StaticOrder S; S.init(MTOK, N1B, G, c);
              EpiG1b E{WSP(float, OFF_RSTD), WSP(bf16_t, OFF_Y), WSP(bf16_t, OFF_Y) + (size_t)MTOK * 768, WSP(bf16_t, OFF_SG), WSP(float, OFF_STA), WSP(float, OFF_STB), p.in[5] + (size_t)layer * 768, p.in[8] + (size_t)layer * 768};
              pg8::gemm_phase<EpiG1b, pg8::StaticOrder, false>(lds, g, S, E, nullptr); }
            { int Gl = G; asm volatile("" : "+s"(Gl)); const bool split = (Gl == 256); const int g2G = split ? 128 : G, g2c = split ? c - 128 : c;
              if (g2c >= 0) { pg8::Gemm g{WSP(bf16_t, OFF_CU), WSP(bf16_t, OFF_WGLU), MTOK, 512, 512}; pg8::StaticOrder S; S.init(MTOK, 512, g2G, g2c);
                  EpiG2 E{WSP(bf16_t, OFF_CU), WSP(bf16_t, OFF_SCZ), WSP(bf16_t, OFF_Y2)};
                  pg8::gemm_phase<EpiG2, pg8::StaticOrder, false>(lds, g, S, E, nullptr); } } } break;
        case 5: {
            pg8::Gemm g{WSP(bf16_t, OFF_Y), WSP(bf16_t, OFF_WBR), 3 * MTOK, 3 * 1024, 768}; BranchOrder S{G, c}; EpiG3 E{WSP(bf16_t, OFF_SG), WSP(bf16_t, OFF_MERGED)};
            pg8::gemm_phase<EpiG3, BranchOrder, false>(lds, g, S, E, nullptr); } break;
        default: {
            pg8::Gemm g{WSP(bf16_t, OFF_MERGED), WSP(bf16_t, OFF_WOUT), MTOK, 1024, 1024}; pg8::StaticOrder S; S.init(MTOK, 1024, G, c);
            EpiG4 E{layer == 0 ? p.in[0] : p.out, p.out, WSP(bf16_t, OFF_XW), layer == 0 ? p.in[1] + 1024 : p.in[22], WSP(float, OFF_RSS), layer == 0 ? 1 : 0};
            pg8::gemm_phase<EpiG4, pg8::StaticOrder, false>(lds, g, S, E, nullptr); } break;
        }
#ifdef PROBE_K
        if (k == PROBE_K) { const unsigned long long tp1 = __builtin_amdgcn_s_memrealtime(); while (__builtin_amdgcn_s_memrealtime() - tp1 < tp1 - tp0) __builtin_amdgcn_s_sleep(8); }
#endif
        xcd_barrier(xbar);
    }
    { Params p = p0; p.ws = (unsigned char*)(__attribute__((address_space(1))) unsigned char*)p0.ws; p.out = (float*)(__attribute__((address_space(1))) float*)p0.out; p.in[22] = (const float*)(__attribute__((address_space(1))) const float*)p0.in[22]; const int G = gridDim.x, c = blockIdx.x; int tid_l = threadIdx.x; asm volatile("" : "+v"(tid_l)); const int tid = tid_l, lane = tid & 63, wid = tid >> 6; const float* fn = p.in[22]; const float* RSS = WSP(float, OFF_RSS);
      f32x4 nv[4];
#pragma unroll
      for (int i = 0; i < 4; ++i) nv[i] = *(const f32x4*)(fn + i * 256 + lane * 4);
      for (int row = c * 8 + wid; row < MTOK; row += G * 8) { const float rs = row_rstd(RSS, row);
#pragma unroll
          for (int i = 0; i < 4; ++i) { float* op = p.out + (size_t)row * 1024 + i * 256 + lane * 4; const f32x4 v = *(const f32x4*)op; *(f32x4*)op = v * rs * nv[i]; } } }
#undef WSP
}

extern "C" void kernel_launch(void* const* d_in, const int* in_sizes, int n_in, void* d_out, int out_size, void* d_ws, size_t ws_size, hipStream_t stream) {
    static int grid_blocks = 0;
    if (grid_blocks == 0) {
        if (n_in != 23 || ws_size < WS_END) { fprintf(stderr, "kernel_launch: need 23 inputs and %zu bytes of workspace (got %d, %zu)\n", (size_t)WS_END, n_in, ws_size); grid_blocks = -1; return; }
        int dev = 0, cus = 0, per_cu = 0;
        hipGetDevice(&dev); hipDeviceGetAttribute(&cus, hipDeviceAttributeMultiprocessorCount, dev);
        if (hipFuncSetAttribute((const void*)hybrid_fwd, hipFuncAttributeMaxDynamicSharedMemorySize, LDS_BYTES) != hipSuccess) { fprintf(stderr, "kernel_launch: hipFuncSetAttribute failed\n"); grid_blocks = -1; return; }
        if (hipOccupancyMaxActiveBlocksPerMultiprocessor(&per_cu, (const void*)hybrid_fwd, NTHR, LDS_BYTES) != hipSuccess || per_cu < 1) per_cu = 1;
        (void)hipGetLastError();
        grid_blocks = cus * 1;
    }
    if (grid_blocks < 0) return;
    Params p{};
    for (int i = 0; i < 23; ++i) p.in[i] = (const float*)d_in[i];
    p.out = (float*)d_out; p.ws = (unsigned char*)d_ws;
    if (hipMemsetAsync((char*)d_ws + OFF_BAR, 0, BAR_BYTES, stream) != hipSuccess) { fprintf(stderr, "memset failed\n"); return; }
    void* args[] = {&p};
    hipError_t e = hipLaunchCooperativeKernel((const void*)hybrid_fwd, dim3(grid_blocks), dim3(NTHR), args, LDS_BYTES, stream);
    if (e != hipSuccess) fprintf(stderr, "cooperative launch failed: %s (grid %d)\n", hipGetErrorString(e), grid_blocks);
}
```
